# Optimizing an MI355X kernel written in HIP

```python
import math
import jax, jax.numpy as jnp
from jax import lax
import numpy as np

D_MODEL = 1024
BATCH = 8
SEQ = 4096
DEPTH = 1

MEM_LEN = 256
GLA_HEADS = 4
GLA_DK = D_MODEL // 8
GLA_DV = D_MODEL // 4
GLA_QK = GLA_HEADS * GLA_DK
GLA_VW = GLA_HEADS * GLA_DV
GLA_RANK = 16
GLA_GATE_TEMP = 16.0
CHUNK = 64
POOL_GROUPS = 4
POOL_WIDTH = D_MODEL // 2
POOL_GC = POOL_WIDTH // POOL_GROUPS
POOL_WINDOWS = (2, 4, 8, 16)
XA_HEADS = 4
XA_HD = D_MODEL // XA_HEADS
D_FF = 2816
EPS = 1e-6
IN_SIZES = (GLA_QK, GLA_QK, GLA_VW, GLA_VW, GLA_RANK, POOL_WIDTH, D_MODEL, D_MODEL)
IN_TOTAL = sum(IN_SIZES)

kernel_name = "hybrid_gla_pool_gated_macaron"


def rmsnorm(x, g):
    x32 = x.astype(jnp.float32)
    r = lax.rsqrt(jnp.mean(x32 * x32, axis=-1, keepdims=True) + EPS)
    return (x32 * r * g.astype(jnp.float32)).astype(x.dtype)


def swiglu(h, w1, w3, w2):
    return (jax.nn.silu(h @ w1) * (h @ w3)) @ w2


def split_cols(t, sizes):
    out, o = [], 0
    for s in sizes:
        out.append(t[..., o:o + s])
        o += s
    return out


def gla_chunked(q, k, v, log_a):
    B, H, S, dk = q.shape
    dv = v.shape[-1]
    n_chunks = S // CHUNK

    def to_chunks(t):
        return jnp.moveaxis(t.astype(jnp.float32).reshape(B, H, n_chunks, CHUNK, t.shape[-1]), 2, 0)

    qc, kc, vc, ac = to_chunks(q), to_chunks(k), to_chunks(v), to_chunks(log_a)
    causal = jnp.tril(jnp.ones((CHUNK, CHUNK), dtype=bool))[None, None, :, :, None]

    def step(state, inp):
        qi, ki, vi, ai = inp
        b = jnp.cumsum(ai, axis=2)
        diff = b[:, :, :, None, :] - b[:, :, None, :, :]
        decay = jnp.exp(jnp.where(causal, diff, -jnp.inf))
        scores = jnp.einsum('bhijk,bhjk->bhij', qi[:, :, :, None, :] * decay, ki)
        o_intra = jnp.einsum('bhij,bhjv->bhiv', scores, vi)
        o_inter = jnp.einsum('bhik,bhkv->bhiv', qi * jnp.exp(b), state)
        b_last = b[:, :, -1:, :]
        k_dec = ki * jnp.exp(b_last - b)
        new_state = jnp.exp(b_last[:, :, 0, :])[..., None] * state + jnp.einsum('bhjk,bhjv->bhkv', k_dec, vi)
        return new_state, o_intra + o_inter

    state0 = jnp.zeros((B, H, dk, dv), jnp.float32)
    _, ys = lax.scan(step, state0, (qc, kc, vc, ac))
    return jnp.moveaxis(ys, 0, 2).reshape(B, H, S, dv).astype(v.dtype)


def trailing_mean(u, w):
    S = u.shape[1]
    cs = jnp.cumsum(u.astype(jnp.float32), axis=1)
    shifted = jnp.pad(cs, ((0, 0), (w, 0), (0, 0)))[:, :S]
    count = jnp.minimum(jnp.arange(1, S + 1), w).astype(jnp.float32)
    return ((cs - shifted) / count[None, :, None]).astype(u.dtype)


def hybrid_mixer(h, w_in, w_alpha, b_alpha, gla_head_norm, w_up_a, pool_mix, pool_scale, w_up_b, w_mix_out):
    B, S, _ = h.shape
    proj = h @ w_in
    q, k, v, r, a_code, u, ga, gb = split_cols(proj, IN_SIZES)

    log_a = jax.nn.log_sigmoid((a_code @ w_alpha + b_alpha).astype(jnp.float32)) / GLA_GATE_TEMP

    def heads(t, d):
        return t.reshape(B, S, GLA_HEADS, d).transpose(0, 2, 1, 3)

    o = gla_chunked(heads(q * (GLA_DK ** -0.5), GLA_DK), heads(k, GLA_DK), heads(v, GLA_DV), heads(log_a, GLA_DK))
    o = rmsnorm(o.transpose(0, 2, 1, 3), gla_head_norm)
    o = o.reshape(B, S, GLA_VW) * jax.nn.silu(r)
    y_a = o @ w_up_a

    ug = u.reshape(B, S, POOL_GROUPS, POOL_GC)
    pooled = jnp.stack([trailing_mean(ug[:, :, g, :], POOL_WINDOWS[g]) for g in range(POOL_GROUPS)], axis=2)
    z = jnp.einsum('bsgc,gcd->bsgd', pooled - ug, pool_mix)
    z = z * pool_scale.reshape(POOL_GROUPS, POOL_GC)
    y_b = z.reshape(B, S, POOL_WIDTH) @ w_up_b

    merged = jax.nn.sigmoid(ga) * y_a + jax.nn.sigmoid(gb) * y_b
    return merged @ w_mix_out


def cross_attention(h, m, wq, wk, wv, wo):
    B, S, _ = h.shape
    M = m.shape[1]
    q = (h @ wq).reshape(B, S, XA_HEADS, XA_HD)
    k = (m @ wk).reshape(B, M, XA_HEADS, XA_HD)
    v = (m @ wv).reshape(B, M, XA_HEADS, XA_HD)
    s = jnp.einsum('bshd,bmhd->bhsm', q, k).astype(jnp.float32) * (XA_HD ** -0.5)
    p = jax.nn.softmax(s, axis=-1).astype(v.dtype)
    o = jnp.einsum('bhsm,bmhd->bshd', p, v).reshape(B, S, D_MODEL)
    return o @ wo


def setup_inputs(seed: int = 0) -> dict:
    key = jax.random.key(seed)
    ks = iter(jax.random.split(key, 40))

    def nrm(shape, fan_in):
        return jax.random.normal(next(ks), shape, jnp.float32) * (fan_in ** -0.5)

    def gain(shape):
        return 1.0 + 0.02 * jax.random.normal(next(ks), shape, jnp.float32)

    L = DEPTH
    return {
        "x": jax.random.normal(next(ks), (BATCH, SEQ, D_MODEL), jnp.float32),
        "mem": jax.random.normal(next(ks), (BATCH, MEM_LEN, D_MODEL), jnp.float32),
        "ffn1_norm": gain((L, D_MODEL)),
        "ffn1_w1": nrm((L, D_MODEL, D_FF), D_MODEL),
        "ffn1_w3": nrm((L, D_MODEL, D_FF), D_MODEL),
        "ffn1_w2": nrm((L, D_FF, D_MODEL), D_FF),
        "mix_norm": gain((L, D_MODEL)),
        "w_in": nrm((L, D_MODEL, IN_TOTAL), D_MODEL),
        "w_alpha": nrm((L, GLA_RANK, GLA_QK), GLA_RANK),
        "b_alpha": 2.0 + 0.5 * jax.random.normal(next(ks), (L, GLA_QK), jnp.float32),
        "gla_head_norm": gain((L, GLA_DV)),
        "w_up_a": nrm((L, GLA_VW, D_MODEL), GLA_VW),
        "pool_mix": nrm((L, POOL_GROUPS, POOL_GC, POOL_GC), POOL_GC),
        "pool_scale": 0.5 + 0.1 * jax.random.normal(next(ks), (L, POOL_WIDTH), jnp.float32),
        "w_up_b": nrm((L, POOL_WIDTH, D_MODEL), POOL_WIDTH),
        "w_mix_out": nrm((L, D_MODEL, D_MODEL), D_MODEL),
        "xa_norm": gain((L, D_MODEL)),
        "mem_norm": gain((L, D_MODEL)),
        "xa_wq": nrm((L, D_MODEL, D_MODEL), D_MODEL),
        "xa_wk": nrm((L, D_MODEL, D_MODEL), D_MODEL),
        "xa_wv": nrm((L, D_MODEL, D_MODEL), D_MODEL),
        "xa_wo": nrm((L, D_MODEL, D_MODEL), D_MODEL),
        "ffn2_norm": gain((L, D_MODEL)),
        "ffn2_w1": nrm((L, D_MODEL, D_FF), D_MODEL),
        "ffn2_w3": nrm((L, D_MODEL, D_FF), D_MODEL),
        "ffn2_w2": nrm((L, D_FF, D_MODEL), D_FF),
        "final_norm": gain((D_MODEL,)),
    }


def reference(x, mem, ffn1_norm, ffn1_w1, ffn1_w3, ffn1_w2, mix_norm, w_in, w_alpha, b_alpha,
              gla_head_norm, w_up_a, pool_mix, pool_scale, w_up_b, w_mix_out, xa_norm, mem_norm,
              xa_wq, xa_wk, xa_wv, xa_wo, ffn2_norm, ffn2_w1, ffn2_w3, ffn2_w2, final_norm):
    for l in range(DEPTH):
        x = x + 0.5 * swiglu(rmsnorm(x, ffn1_norm[l]), ffn1_w1[l], ffn1_w3[l], ffn1_w2[l])
        x = x + hybrid_mixer(rmsnorm(x, mix_norm[l]), w_in[l], w_alpha[l], b_alpha[l], gla_head_norm[l],
                             w_up_a[l], pool_mix[l], pool_scale[l], w_up_b[l], w_mix_out[l])
        x = x + cross_attention(rmsnorm(x, xa_norm[l]), rmsnorm(mem, mem_norm[l]),
                                xa_wq[l], xa_wk[l], xa_wv[l], xa_wo[l])
        x = x + 0.5 * swiglu(rmsnorm(x, ffn2_norm[l]), ffn2_w1[l], ffn2_w3[l], ffn2_w2[l])
    return rmsnorm(x, final_norm)
```

```cpp
#include <hip/hip_runtime.h>
#include <hip/hip_cooperative_groups.h>
#include <cstdio>
#include <cstdint>
namespace cg = cooperative_groups;

#ifndef MK_ONE_LAUNCH
#define MK_ONE_LAUNCH 1
#endif

#define LAS __attribute__((address_space(3)))
typedef unsigned short bf16_t;
typedef short bf16x8 __attribute__((ext_vector_type(8)));
typedef short bf16x4 __attribute__((ext_vector_type(4)));
typedef float f32x4 __attribute__((ext_vector_type(4)));
typedef float f32x2 __attribute__((ext_vector_type(2)));
typedef unsigned u32x4 __attribute__((ext_vector_type(4)));
typedef unsigned u32x2 __attribute__((ext_vector_type(2)));

constexpr int T = 32768, D = 1024, FF = 2816, SEQ = 4096, NBATCH = 8, MEMLEN = 256;
constexpr int NPROJ = 5632;
constexpr int PQ0 = 0, PK0 = 512, PV0 = 1024, PR0 = 2048, PU0 = 3072, PGA0 = 3584, PGB0 = 4608;
constexpr int WIN_LD = 5648;
constexpr float EPS = 1e-6f;
constexpr int NPHASE = 14;

constexpr size_t MiB = 1u << 20;
constexpr size_t WS_SSQ = 0, WS_ACODE = 2 * MiB, WS_LDG = 4 * MiB, WS_KV = 5 * MiB, WS_MB = 13 * MiB;
constexpr size_t WS_CTL = 18 * MiB, CTL_BYTES = 16384;
constexpr size_t WS_W = 20 * MiB;
constexpr size_t W_1C1 = WS_W, W_21 = W_1C1 + (size_t)5632 * 1024 * 2, W_IN = W_21 + (size_t)1024 * 2816 * 2, W_AT = W_IN + (size_t)5632 * 1024 * 2,
                 W_UPA = W_AT + 32768, W_PB = W_UPA + 2 * MiB, W_MIX = W_PB + MiB, W_Q = W_MIX + 2 * MiB, W_KV = W_Q + 2 * MiB, W_O = W_KV + 4 * MiB,
                 W_1C2 = W_O + 2 * MiB, W_22 = W_1C2 + (size_t)5632 * 1024 * 2, W_END = W_22 + (size_t)1024 * 2816 * 2;
static_assert(W_END <= 80 * MiB && W_IN >= W_1C1 + 16 * MiB, "weight region");
constexpr size_t WS_XB = 80 * MiB, WS_PB = 80 * MiB, WS_STG = 112 * MiB;
constexpr size_t WS_PROJ = 144 * MiB, WS_H = WS_PROJ, WS_PR = WS_PROJ + 64 * MiB;
constexpr size_t WS_VWOT = 496 * MiB;
constexpr size_t WS_WQK = W_1C1;
constexpr size_t WS_END = WS_PROJ + (size_t)T * NPROJ * 2;
static_assert(WS_END <= 512 * MiB, "d_ws map");

constexpr int RING_BYTES = 131072, EPI_LDS_OFF = RING_BYTES, LDS_BYTES = 147456;

__device__ __forceinline__ unsigned f2bf(float f) { unsigned u = __builtin_bit_cast(unsigned, f); return (u + 0x7fffu + ((u >> 16) & 1u)) >> 16; }
__device__ __forceinline__ unsigned pk2(float lo, float hi) { unsigned r; asm("v_cvt_pk_bf16_f32 %0, %1, %2" : "=v"(r) : "v"(lo), "v"(hi)); return r; }
__device__ __forceinline__ unsigned pk2m(float lo, float hi) { return f2bf(lo) | (f2bf(hi) << 16); }
__device__ __forceinline__ float bf2f(unsigned short b) { return __builtin_bit_cast(float, (unsigned)b << 16); }
__device__ __forceinline__ float bflo(unsigned w) { return __builtin_bit_cast(float, w << 16); }
__device__ __forceinline__ float bfhi(unsigned w) { return __builtin_bit_cast(float, w & 0xffff0000u); }
__device__ __forceinline__ float sigmoidf_(float x) { return __builtin_amdgcn_rcpf(1.f + __expf(-x)); }
__device__ __forceinline__ float siluf_(float x) { return x * sigmoidf_(x); }
__device__ __forceinline__ float wave_sum(float v) {
#pragma unroll
    for (int o = 1; o < 64; o <<= 1) v += __shfl_xor(v, o);
    return v;
}
#define LDS_WAIT() asm volatile("s_waitcnt lgkmcnt(0)" ::: "memory")

namespace pg8 {
constexpr int BM = 256, BK = 64, HALF = 128, HTB = HALF * BK * 2, NXCD = 8, WGM = 8;
__host__ __device__ __forceinline__ int lds_byte(int r, int c) { const int st = (r >> 4) * 2 + (c >> 5), rr = r & 15, cc = c & 31, ob = rr * 64 + cc * 2; return st * 1024 + (ob ^ (((ob >> 9) & 1) << 5)); }
__host__ __device__ __forceinline__ void stage_rc(int b, int& R, int& C) { const int st = b / 1024, sb = b % 1024, swz = sb ^ (((sb >> 9) & 1) << 5); R = (st >> 1) * 16 + swz / 64; C = (st & 1) * 32 + (swz % 64) / 2; }
__host__ __device__ __forceinline__ int perm32(int rho) { const int n = rho >> 4, i = rho & 15; return 8 * (i >> 2) + 4 * n + (i & 3); }

struct Unit { int pm, pn, kind; };

struct GridOrder {
    int nM, nN, nwg, G, c;
    __device__ __forceinline__ void init(int nM_, int nN_, int G_, int c_) { nM = nM_; nN = nN_; nwg = nM * nN; G = G_; c = c_; }
    __device__ __forceinline__ bool map(int L, Unit& u) const {
        if (L >= nwg) return false;
        int wgid = L; { const int q = nwg / NXCD, r = nwg % NXCD, xcd = wgid % NXCD, off = wgid / NXCD; wgid = (xcd < r ? xcd * (q + 1) : r * (q + 1) + (xcd - r) * q) + off; }
        const int nig = WGM * nN, gid = wgid / nig, fm = gid * WGM, gsz = (nM - fm) < WGM ? (nM - fm) : WGM;
        u.pm = fm + ((wgid % nig) % gsz); u.pn = (wgid % nig) / gsz; u.kind = 0; return true;
    }
};

template <class Epi, class Sched>
__device__ __forceinline__ void gemm_phase(LAS unsigned char* lds, const int K, const int lda, const int ldb, const Sched& S, const Epi& E) {
    const int tid = threadIdx.x, wid = __builtin_amdgcn_readfirstlane(tid >> 6), lane = tid & 63, wr = wid >> 2, wc = wid & 3, fr = lane & 15, fq = lane >> 4;
    int nt = K / BK; asm volatile("" : "+s"(nt));
    unsigned voffA[2], voffB[2];
#pragma unroll
    for (int i = 0; i < 2; ++i) { int R, C; stage_rc(tid * 16 + i * 8192, R, C); const int Rb = Epi::PERM ? ((R & ~31) + perm32(R & 31)) : R;
        voffA[i] = (unsigned)(R * lda + C) * 2u; voffB[i] = (unsigned)(Rb * ldb + C) * 2u; }
    const size_t kstep = (size_t)(BK * 2);
    const size_t hstepA = (size_t)HALF * lda * 2, hstepB = (size_t)HALF * ldb * 2;
    const unsigned ldsw = (unsigned)wid * 1024u;
    const int aoff = lds_byte(wr * 64 + fr, fq * 8), boff = lds_byte(wc * 32 + fr, fq * 8);
#define PG8_SA(b, h) (((b) * 2 + (h)) * HTB)
#define PG8_SB(b, h) ((4 + (b) * 2 + (h)) * HTB)
#define PG8_STAGE(bufoff, gbase, voff) do { _Pragma("unroll") for (int _i = 0; _i < 2; ++_i) \
        __builtin_amdgcn_global_load_lds((const unsigned*)((const char*)(gbase) + (voff)[_i]), (LAS unsigned*)(lds + (bufoff) + ldsw + _i * 8192), 16, 0, 0); } while (0)
#define PG8_LDA(dst, b, h) do { _Pragma("unroll") for (int m = 0; m < 4; ++m) _Pragma("unroll") for (int k = 0; k < 2; ++k) dst[m][k] = *(const LAS bf16x8*)(lds + PG8_SA(b, h) + aoff + m * 2048 + k * 1024); } while (0)
#define PG8_LDB(dst, b, h) do { _Pragma("unroll") for (int n = 0; n < 2; ++n) _Pragma("unroll") for (int k = 0; k < 2; ++k) dst[n][k] = *(const LAS bf16x8*)(lds + PG8_SB(b, h) + boff + n * 2048 + k * 1024); } while (0)
#define PG8_MMA(ai, bj, At, Bt) do { __builtin_amdgcn_s_setprio(1); _Pragma("unroll") for (int m = 0; m < 4; ++m) _Pragma("unroll") for (int n = 0; n < 2; ++n) _Pragma("unroll") for (int k = 0; k < 2; ++k) \
        acc[ai][bj][m][n] = __builtin_amdgcn_mfma_f32_16x16x32_bf16(Bt[n][k], At[m][k], acc[ai][bj][m][n], 0, 0, 0); __builtin_amdgcn_s_setprio(0); } while (0)
#define PG8_WAIT_V(n) asm volatile("s_waitcnt vmcnt(" #n ")" ::: "memory")
#define PG8_WAIT_L(n) asm volatile("s_waitcnt lgkmcnt(" #n ")" ::: "memory")
#define PG8_BAR __builtin_amdgcn_s_barrier()
#define PG8_SCHED __builtin_amdgcn_sched_barrier(0)
    Unit cur, nxt; int ui = 0;
    if (!S.next(0, cur)) return;
    f32x4 acc[2][2][4][2];
#pragma unroll
    for (int a = 0; a < 2; ++a)
#pragma unroll
        for (int b = 0; b < 2; ++b)
#pragma unroll
            for (int m = 0; m < 4; ++m)
#pragma unroll
                for (int n = 0; n < 2; ++n) acc[a][b][m][n] = (f32x4){0.f, 0.f, 0.f, 0.f};
    bf16x8 At[4][2], B0[2][2], B1[2][2];
    const char* cA = S.a(cur); const char* cB = S.b(cur);
    PG8_STAGE(PG8_SB(0, 0), cB, voffB); PG8_STAGE(PG8_SB(0, 1), cB + hstepB, voffB); PG8_STAGE(PG8_SA(0, 0), cA, voffA); PG8_STAGE(PG8_SA(0, 1), cA + hstepA, voffA);
    if (wr == 1) PG8_BAR;
    PG8_WAIT_V(2); PG8_BAR;
    PG8_STAGE(PG8_SB(1, 0), cB + kstep, voffB); PG8_STAGE(PG8_SA(1, 0), cA + kstep, voffA); PG8_STAGE(PG8_SB(1, 1), cB + hstepB + kstep, voffB);
    PG8_WAIT_V(6); PG8_BAR;
    for (;;) {
        const bool has_next = S.next(ui + 1, nxt);
        const char* nA = has_next ? S.a(nxt) : cA; const char* nB = has_next ? S.b(nxt) : cB;
        for (int t = 0; t < nt; t += 2) {
            const bool last = (t == nt - 2);
            const char* a1 = cA + (size_t)(t + 1) * kstep;
            const char* a2 = last ? nA : cA + (size_t)(t + 2) * kstep; const char* b2 = last ? nB : cB + (size_t)(t + 2) * kstep;
            const char* a3 = a2 + kstep; const char* b3 = b2 + kstep;
            PG8_LDB(B0, 0, 0); PG8_LDB(B1, 0, 1); PG8_SCHED; PG8_LDA(At, 0, 0); PG8_STAGE(PG8_SA(1, 1), a1 + hstepA, voffA);
            PG8_WAIT_V(8); PG8_WAIT_L(0); PG8_BAR; PG8_MMA(0, 0, At, B0); PG8_MMA(0, 1, At, B1); PG8_BAR; PG8_SCHED;
            PG8_LDA(At, 0, 1); PG8_STAGE(PG8_SB(0, 0), b2, voffB); PG8_STAGE(PG8_SB(0, 1), b2 + hstepB, voffB); PG8_STAGE(PG8_SA(0, 0), a2, voffA);
            PG8_WAIT_V(8); PG8_WAIT_L(0); PG8_BAR; PG8_MMA(1, 0, At, B0); PG8_MMA(1, 1, At, B1); PG8_BAR; PG8_SCHED;
            PG8_LDB(B0, 1, 0); PG8_LDB(B1, 1, 1); PG8_SCHED; PG8_LDA(At, 1, 0); PG8_STAGE(PG8_SA(0, 1), a2 + hstepA, voffA);
            PG8_WAIT_V(8); PG8_WAIT_L(0); PG8_BAR; PG8_MMA(0, 0, At, B0); PG8_MMA(0, 1, At, B1); PG8_BAR; PG8_SCHED;
            PG8_LDA(At, 1, 1); PG8_STAGE(PG8_SB(1, 0), b3, voffB); PG8_STAGE(PG8_SB(1, 1), b3 + hstepB, voffB); PG8_STAGE(PG8_SA(1, 0), a3, voffA);
            PG8_WAIT_V(8); PG8_WAIT_L(0); PG8_BAR; PG8_MMA(1, 0, At, B0); PG8_MMA(1, 1, At, B1); PG8_BAR; PG8_SCHED;
        }
        if (wr == 0) PG8_BAR;
        E(acc, cur, wr, wc, fr, fq);
        if (!has_next) break;
#pragma unroll
        for (int a = 0; a < 2; ++a)
#pragma unroll
            for (int b = 0; b < 2; ++b)
#pragma unroll
                for (int m = 0; m < 4; ++m)
#pragma unroll
                    for (int n = 0; n < 2; ++n) acc[a][b][m][n] = (f32x4){0.f, 0.f, 0.f, 0.f};
        cur = nxt; cA = nA; cB = nB; ++ui;
        if (wr == 1) PG8_BAR;
    }
    PG8_WAIT_V(0);
    PG8_BAR;
#undef PG8_SA
#undef PG8_SB
#undef PG8_STAGE
#undef PG8_LDA
#undef PG8_LDB
#undef PG8_MMA
#undef PG8_WAIT_V
#undef PG8_WAIT_L
#undef PG8_SCHED
}
}
using pg8::Unit;
typedef f32x4 Acc[2][2][4][2];

struct SchedPlain {
    pg8::GridOrder o; const char* A; const char* B; size_t ta, tb;
    __device__ __forceinline__ bool next(int i, Unit& u) const { return o.map(i * o.G + o.c, u); }
    __device__ __forceinline__ const char* a(const Unit& u) const { return A + (size_t)u.pm * ta; }
    __device__ __forceinline__ const char* b(const Unit& u) const { return B + (size_t)u.pn * tb; }
};
struct SchedUpKV {
    pg8::GridOrder o; const char* ws; size_t offA, offB;
    __device__ __forceinline__ bool next(int i, Unit& u) const { const int L = i * o.G + o.c; if (L < o.nwg) return o.map(L, u); const int r = L - o.nwg; if (r >= 64) return false;
        u.pm = r & 7; u.pn = r >> 3; u.kind = 1; return true; }
    __device__ __forceinline__ const char* a(const Unit& u) const { return ws + (u.kind == 0 ? offA : WS_MB) + (size_t)u.pm * (256 * 1024 * 2); }
    __device__ __forceinline__ const char* b(const Unit& u) const { return ws + (u.kind == 0 ? offB : W_KV) + (size_t)u.pn * (256 * 1024 * 2); }
};
struct SchedAttn {
    int G, c; const char* A; const char* B;
    __device__ __forceinline__ bool next(int i, Unit& u) const { const int L = i * G + c; if (L >= 512) return false; u.pm = L >> 2; u.pn = L & 3; u.kind = 0; return true; }
    __device__ __forceinline__ const char* a(const Unit& u) const { return A + (size_t)u.pm * (256 * 1024 * 2); }
    __device__ __forceinline__ const char* b(const Unit& u) const { return B + (size_t)(u.pm >> 4) * (2 * MiB) + (size_t)u.pn * (256 * 1024 * 2); }
};
struct SchedPre {
    int G, c, mode; const char* KV; const char* W;
    __device__ __forceinline__ bool next(int i, Unit& u) const { const int L = i * G + c; if (L >= 128) return false; u.pm = L >> 2; u.pn = L & 3; u.kind = 0; return true; }
    __device__ __forceinline__ const char* kv(const Unit& u) const { return KV + (size_t)(u.pm >> 2) * (256 * 2048 * 2) + (mode ? 2048 : 0) + (size_t)(u.pm & 3) * 512; }
    __device__ __forceinline__ const char* w(const Unit& u) const { return W + (size_t)u.pn * (256 * 1024 * 2) + (size_t)(u.pm & 3) * 512; }
    __device__ __forceinline__ const char* a(const Unit& u) const { return mode ? w(u) : kv(u); }
    __device__ __forceinline__ const char* b(const Unit& u) const { return mode ? kv(u) : w(u); }
};

__device__ __forceinline__ float row_rs(const float* ssq, int row) {
    const f32x4* p = (const f32x4*)(ssq + (size_t)row * 16);
    const f32x4 a = p[0], b = p[1], c = p[2], d = p[3];
    const float s = ((a[0] + a[1]) + (a[2] + a[3])) + ((b[0] + b[1]) + (b[2] + b[3])) + ((c[0] + c[1]) + (c[2] + c[3])) + ((d[0] + d[1]) + (d[2] + d[3]));
    return __builtin_amdgcn_rsqf(s * (1.0f / D) + EPS);
}
__device__ __forceinline__ float row_rs4(const float* ssq, int row, int fq) {
    const f32x4 a = *(const f32x4*)(ssq + (size_t)row * 16 + 4 * fq);
    float s = (a[0] + a[1]) + (a[2] + a[3]);
    s += __shfl_xor(s, 16); s += __shfl_xor(s, 32);
    return __builtin_amdgcn_rsqf(s * (1.0f / D) + EPS);
}
__device__ __forceinline__ void rows_rs(const float* ssq, int row0, int fq, float (&rr)[2][4]) {
    f32x4 p[2][4];
#pragma unroll
    for (int ai = 0; ai < 2; ++ai)
#pragma unroll
        for (int m = 0; m < 4; ++m) p[ai][m] = *(const f32x4*)(ssq + (size_t)(row0 + ai * 128 + m * 16) * 16 + 4 * fq);
    asm volatile("" ::: "memory");
#pragma unroll
    for (int ai = 0; ai < 2; ++ai)
#pragma unroll
        for (int m = 0; m < 4; ++m) { float s = (p[ai][m][0] + p[ai][m][1]) + (p[ai][m][2] + p[ai][m][3]); s += __shfl_xor(s, 16); s += __shfl_xor(s, 32); rr[ai][m] = __builtin_amdgcn_rsqf(s * (1.0f / D) + EPS); }
}
__device__ __forceinline__ u32x4 pack8(const f32x4 v0, const f32x4 v1) { u32x4 w; w.x = pk2(v0[0], v0[1]); w.y = pk2(v0[2], v0[3]); w.z = pk2(v1[0], v1[1]); w.w = pk2(v1[2], v1[3]); return w; }

struct EpiSwiGLU {
    static constexpr bool PERM = true;
    bf16_t* H; const float* ssq; bf16_t* KV;
    __device__ __forceinline__ void operator()(Acc& acc, const Unit& u, int wr, int wc, int fr, int fq) const {
        if (u.kind == 0) {
            float rr[2][4]; rows_rs(ssq, u.pm * 256 + wr * 64 + fr, fq, rr);
#pragma unroll
            for (int ai = 0; ai < 2; ++ai)
#pragma unroll
                for (int m = 0; m < 4; ++m) {
                    const int row = u.pm * 256 + ai * 128 + wr * 64 + m * 16 + fr; const float r = rr[ai][m];
                    f32x4 h0, h1;
#pragma unroll
                    for (int j = 0; j < 4; ++j) { h0[j] = siluf_(acc[ai][0][m][0][j] * r) * (acc[ai][1][m][0][j] * r); h1[j] = siluf_(acc[ai][0][m][1][j] * r) * (acc[ai][1][m][1][j] * r); }
                    *(u32x4*)(H + (size_t)row * FF + u.pn * 128 + wc * 32 + 8 * fq) = pack8(h0, h1);
                }
        } else {
            bf16_t* base = KV + (size_t)(u.pm * 256) * 2048 + u.pn * 256;
#pragma unroll
            for (int ai = 0; ai < 2; ++ai)
#pragma unroll
                for (int m = 0; m < 4; ++m) { const int rl = ai * 128 + wr * 64 + m * 16 + fr;
#pragma unroll
                    for (int bj = 0; bj < 2; ++bj) *(u32x4*)(base + (size_t)rl * 2048 + bj * 128 + wc * 32 + 8 * fq) = pack8(acc[ai][bj][m][0], acc[ai][bj][m][1]); }
        }
    }
};
struct EpiPre {
    static constexpr bool PERM = true;
    bf16_t* O; int mode;
    __device__ __forceinline__ void operator()(Acc& acc, const Unit& u, int wr, int wc, int fr, int fq) const {
        bf16_t* base = O + (size_t)(u.pm >> 2) * 1048576 + (mode ? (size_t)(u.pn * 256) * 1024 + (u.pm & 3) * 256 : (size_t)((u.pm & 3) * 256) * 1024 + u.pn * 256);
#pragma unroll
        for (int ai = 0; ai < 2; ++ai)
#pragma unroll
            for (int m = 0; m < 4; ++m) { const int rl = ai * 128 + wr * 64 + m * 16 + fr;
#pragma unroll
                for (int bj = 0; bj < 2; ++bj) *(u32x4*)(base + (size_t)rl * 1024 + bj * 128 + wc * 32 + 8 * fq) = pack8(acc[ai][bj][m][0], acc[ai][bj][m][1]); }
    }
};
struct EpiResid {
    static constexpr bool PERM = true;
    bf16_t* xb; float* ssq; float alpha;
    __device__ __forceinline__ void operator()(Acc& acc, const Unit& u, int wr, int wc, int fr, int fq) const {
#pragma unroll
        for (int ai = 0; ai < 2; ++ai)
#pragma unroll
            for (int m = 0; m < 4; ++m) {
                const int row = u.pm * 256 + ai * 128 + wr * 64 + m * 16 + fr; float ss = 0.f;
#pragma unroll
                for (int bj = 0; bj < 2; ++bj) { bf16_t* p = xb + (size_t)row * D + u.pn * 256 + bj * 128 + wc * 32 + 8 * fq; const u32x4 b = *(const u32x4*)p;
                    f32x4 o0, o1; o0[0] = bflo(b.x); o0[1] = bfhi(b.x); o0[2] = bflo(b.y); o0[3] = bfhi(b.y); o1[0] = bflo(b.z); o1[1] = bfhi(b.z); o1[2] = bflo(b.w); o1[3] = bfhi(b.w);
                    o0 = o0 + acc[ai][bj][m][0] * alpha; o1 = o1 + acc[ai][bj][m][1] * alpha;
                    ss += ((o0[0] * o0[0] + o0[1] * o0[1]) + (o0[2] * o0[2] + o0[3] * o0[3])) + ((o1[0] * o1[0] + o1[1] * o1[1]) + (o1[2] * o1[2] + o1[3] * o1[3]));
                    *(u32x4*)p = pack8(o0, o1); }
                ss += __shfl_xor(ss, 16); ss += __shfl_xor(ss, 32);
                if (fq == 0) ssq[(size_t)row * 16 + u.pn * 4 + wc] = ss;
            }
    }
};
template <bool USE_R> struct EpiScaleBf16 {
    static constexpr bool PERM = true;
    bf16_t* O; int ldc; const float* ssq;
    __device__ __forceinline__ void operator()(Acc& acc, const Unit& u, int wr, int wc, int fr, int fq) const {
        float rr[2][4]; if (USE_R) rows_rs(ssq, u.pm * 256 + wr * 64 + fr, fq, rr);
#pragma unroll
        for (int ai = 0; ai < 2; ++ai)
#pragma unroll
            for (int m = 0; m < 4; ++m) { const int row = u.pm * 256 + ai * 128 + wr * 64 + m * 16 + fr; const float r = USE_R ? rr[ai][m] : 1.f;
#pragma unroll
                for (int bj = 0; bj < 2; ++bj) *(u32x4*)(O + (size_t)row * ldc + u.pn * 256 + bj * 128 + wc * 32 + 8 * fq) = pack8(acc[ai][bj][m][0] * r, acc[ai][bj][m][1] * r); }
    }
};
struct EpiYB {
    static constexpr bool PERM = true;
    bf16_t* proj;
    __device__ __forceinline__ void operator()(Acc& acc, const Unit& u, int wr, int wc, int fr, int fq) const {
#pragma unroll
        for (int ai = 0; ai < 2; ++ai)
#pragma unroll
            for (int m = 0; m < 4; ++m) { const int row = u.pm * 256 + ai * 128 + wr * 64 + m * 16 + fr;
#pragma unroll
                for (int bj = 0; bj < 2; ++bj) { bf16_t* p = proj + (size_t)row * NPROJ + PGB0 + u.pn * 256 + bj * 128 + wc * 32 + 8 * fq; const u32x4 g = *(const u32x4*)p;
                    f32x4 v0, v1; v0[0] = sigmoidf_(bflo(g.x)); v0[1] = sigmoidf_(bfhi(g.x)); v0[2] = sigmoidf_(bflo(g.y)); v0[3] = sigmoidf_(bfhi(g.y));
                    v1[0] = sigmoidf_(bflo(g.z)); v1[1] = sigmoidf_(bfhi(g.z)); v1[2] = sigmoidf_(bflo(g.w)); v1[3] = sigmoidf_(bfhi(g.w));
                    *(u32x4*)p = pack8(v0 * acc[ai][bj][m][0], v1 * acc[ai][bj][m][1]); } }
    }
};
struct EpiMG {
    static constexpr bool PERM = true;
    bf16_t* proj;
    __device__ __forceinline__ void operator()(Acc& acc, const Unit& u, int wr, int wc, int fr, int fq) const {
#pragma unroll
        for (int ai = 0; ai < 2; ++ai)
#pragma unroll
            for (int m = 0; m < 4; ++m) { const int row = u.pm * 256 + ai * 128 + wr * 64 + m * 16 + fr;
#pragma unroll
                for (int bj = 0; bj < 2; ++bj) { const int col = u.pn * 256 + bj * 128 + wc * 32 + 8 * fq; bf16_t* p = proj + (size_t)row * NPROJ + PGA0 + col;
                    const u32x4 g = *(const u32x4*)p; const u32x4 y = *(const u32x4*)(proj + (size_t)row * NPROJ + PGB0 + col);
                    f32x4 v0, v1, y0, y1; v0[0] = sigmoidf_(bflo(g.x)); v0[1] = sigmoidf_(bfhi(g.x)); v0[2] = sigmoidf_(bflo(g.y)); v0[3] = sigmoidf_(bfhi(g.y));
                    v1[0] = sigmoidf_(bflo(g.z)); v1[1] = sigmoidf_(bfhi(g.z)); v1[2] = sigmoidf_(bflo(g.w)); v1[3] = sigmoidf_(bfhi(g.w));
                    y0[0] = bflo(y.x); y0[1] = bfhi(y.x); y0[2] = bflo(y.y); y0[3] = bfhi(y.y); y1[0] = bflo(y.z); y1[1] = bfhi(y.z); y1[2] = bflo(y.w); y1[3] = bfhi(y.w);
                    *(u32x4*)p = pack8(v0 * acc[ai][bj][m][0] + y0, v1 * acc[ai][bj][m][1] + y1); } }
    }
};
struct EpiSoftmax {
    static constexpr bool PERM = true;
    bf16_t* O; LAS float* scr; const float* ssq;
    __device__ __forceinline__ void operator()(Acc& acc, const Unit& u, int wr, int wc, int fr, int fq) const {
        LAS float* MX = scr; LAS float* SM = scr + 1024;
        float rr[2][4]; rows_rs(ssq, u.pm * 256 + wr * 64 + fr, fq, rr);
#pragma unroll
        for (int ai = 0; ai < 2; ++ai)
#pragma unroll
            for (int m = 0; m < 4; ++m) { float v = -3.0e38f; const float r = rr[ai][m];
#pragma unroll
                for (int bj = 0; bj < 2; ++bj)
#pragma unroll
                    for (int n = 0; n < 2; ++n)
#pragma unroll
                        for (int j = 0; j < 4; ++j) { acc[ai][bj][m][n][j] *= r; v = fmaxf(v, acc[ai][bj][m][n][j]); }
                v = fmaxf(v, __shfl_xor(v, 16)); v = fmaxf(v, __shfl_xor(v, 32));
                if (fq == 0) MX[(ai * 128 + wr * 64 + m * 16 + fr) * 4 + wc] = v; }
        LDS_WAIT(); __builtin_amdgcn_s_barrier(); asm volatile("" ::: "memory");
#pragma unroll
        for (int ai = 0; ai < 2; ++ai)
#pragma unroll
            for (int m = 0; m < 4; ++m) { const int rl = ai * 128 + wr * 64 + m * 16 + fr; const f32x4 q = *(const LAS f32x4*)(MX + rl * 4);
                const float mxr = fmaxf(fmaxf(q[0], q[1]), fmaxf(q[2], q[3])); float s = 0.f;
#pragma unroll
                for (int bj = 0; bj < 2; ++bj)
#pragma unroll
                    for (int n = 0; n < 2; ++n)
#pragma unroll
                        for (int j = 0; j < 4; ++j) { const float e = __expf(acc[ai][bj][m][n][j] - mxr); acc[ai][bj][m][n][j] = e; s += e; }
                s += __shfl_xor(s, 16); s += __shfl_xor(s, 32);
                if (fq == 0) SM[rl * 4 + wc] = s; }
        LDS_WAIT(); __builtin_amdgcn_s_barrier(); asm volatile("" ::: "memory");
#pragma unroll
        for (int ai = 0; ai < 2; ++ai)
#pragma unroll
            for (int m = 0; m < 4; ++m) { const int rl = ai * 128 + wr * 64 + m * 16 + fr; const f32x4 q = *(const LAS f32x4*)(SM + rl * 4);
                const float inv = __builtin_amdgcn_rcpf((q[0] + q[1]) + (q[2] + q[3])); const int row = u.pm * 256 + rl;
#pragma unroll
                for (int bj = 0; bj < 2; ++bj) *(u32x4*)(O + (size_t)row * 1024 + u.pn * 256 + bj * 128 + wc * 32 + 8 * fq) = pack8(acc[ai][bj][m][0] * inv, acc[ai][bj][m][1] * inv); }
    }
};

struct Args {
    const float* in[27]; float* out; unsigned char* ws; int ph_lo, ph_hi;
};
enum { I_X = 0, I_MEM, I_F1N, I_F1W1, I_F1W3, I_F1W2, I_MIXN, I_WIN, I_WAL, I_BAL, I_GHN, I_WUPA, I_PMIX, I_PSC, I_WUPB, I_WMIX, I_XAN, I_MEMN, I_XWQ, I_XWK, I_XWV, I_XWO,
       I_F2N, I_F2W1, I_F2W3, I_F2W2, I_FN };

__device__ __forceinline__ void cvt_item(const float* W, int ldw, int col0, int k0, const float* gain, float scale, bf16_t* dst, int ldd, int drow0, LAS float* scr, int lane) {
    float v[32], g[32];
    const float* wp = W + (size_t)(k0 + (lane >> 5)) * ldw + col0 + (lane & 31);
#pragma unroll
    for (int i = 0; i < 32; ++i) v[i] = wp[(size_t)(2 * i) * ldw];
    if (gain) {
#pragma unroll
        for (int i = 0; i < 32; ++i) g[i] = gain[k0 + 2 * i + (lane >> 5)];
    }
#pragma unroll
    for (int i = 0; i < 32; ++i) scr[(2 * i + (lane >> 5)) * 33 + (lane & 31)] = v[i] * (gain ? g[i] * scale : scale);
    LDS_WAIT(); asm volatile("" ::: "memory");
    const int c = lane & 7;
#pragma unroll
    for (int j = 0; j < 4; ++j) { const int n = (lane >> 3) + 8 * j; const LAS float* s = scr + (8 * c) * 33 + n;
        u32x4 o; o.x = pk2(s[0 * 33], s[1 * 33]); o.y = pk2(s[2 * 33], s[3 * 33]); o.z = pk2(s[4 * 33], s[5 * 33]); o.w = pk2(s[6 * 33], s[7 * 33]);
        *(u32x4*)(dst + (size_t)(drow0 + n) * ldd + k0 + 8 * c) = o; }
    LDS_WAIT(); asm volatile("" ::: "memory");
}
__device__ __forceinline__ void cvt_plain(const float* W, int K, int N, const float* gain, float scale, bf16_t* dst, int drow_off, LAS float* scr, int it, int lane) {
    const int nblk = N / 32, kb = it / nblk, nb = it % nblk;
    cvt_item(W, N, nb * 32, kb * 64, gain, scale, dst, K, drow_off + nb * 32, scr, lane);
}
__device__ __forceinline__ void cvt_w13(const float* W1, const float* W3, const float* gain, bf16_t* dst, LAS float* scr, int it, int lane) {
    const int nblk = 5632 / 32, kb = it / nblk, nb = it % nblk, pn = nb >> 3, cb = nb & 7;
    cvt_item(cb < 4 ? W1 : W3, FF, pn * 128 + (cb & 3) * 32, kb * 64, gain, 1.f, dst, 1024, nb * 32, scr, lane);
}
__device__ __forceinline__ void cvt_win(const float* W, const float* gain, bf16_t* dst, LAS float* scr, int it, int lane) {
    const int nblk = NPROJ / 32, kb = it / nblk, nb = it % nblk, n0 = nb * 32;
    cvt_item(W, WIN_LD, n0 + (n0 >= 3072 ? 16 : 0), kb * 64, gain, 1.f, dst, 1024, n0, scr, lane);
}
constexpr int PI13 = 176 * 16, PI2 = 32 * 44, PISQ = 32 * 16;
constexpr int PREP_EARLY = PI13 + 2 * PISQ, PREP_NITEMS = 2 * PI13 + PI2 + 6 * PISQ + 1024 + 16;
__device__ __forceinline__ void prep_items(const Args& a, LAS unsigned char* lds, int first, int last, int gw, int NGW) {
    const int tid = threadIdx.x, lane = tid & 63, wave = __builtin_amdgcn_readfirstlane(tid >> 6);
    LAS float* scr = (LAS float*)(lds + wave * 16384);
    unsigned char* ws = a.ws;
    constexpr int I13 = PI13, I2 = PI2, ISQ = PISQ;
    for (int it = first + gw; it < last; it += NGW) {
        int r = it;
        if (r < I13) { cvt_w13(a.in[I_F1W1], a.in[I_F1W3], a.in[I_F1N], (bf16_t*)(ws + W_1C1), scr, r, lane); continue; } r -= I13;
        if (r < ISQ) { cvt_plain(a.in[I_XWK], D, D, a.in[I_MEMN], 1.f, (bf16_t*)(ws + W_KV), 0, scr, r, lane); continue; } r -= ISQ;
        if (r < ISQ) { cvt_plain(a.in[I_XWV], D, D, a.in[I_MEMN], 1.f, (bf16_t*)(ws + W_KV), 1024, scr, r, lane); continue; } r -= ISQ;
        if (r < I2) { cvt_plain(a.in[I_F1W2], FF, D, nullptr, 1.f, (bf16_t*)(ws + W_21), 0, scr, r, lane); continue; } r -= I2;
        if (r < I13) { cvt_win(a.in[I_WIN], a.in[I_MIXN], (bf16_t*)(ws + W_IN), scr, r, lane); continue; } r -= I13;
        if (r < 16) {
            const int k = r * 64 + lane; const float g = a.in[I_MIXN][k]; const float* w = a.in[I_WIN] + (size_t)k * WIN_LD + 3072;
#pragma unroll
            for (int j = 0; j < 16; ++j) ((bf16_t*)(ws + W_AT))[j * 1024 + k] = (bf16_t)f2bf(w[j] * g);
            continue; } r -= 16;
        if (r < ISQ) { cvt_plain(a.in[I_WUPA], D, D, nullptr, 1.f, (bf16_t*)(ws + W_UPA), 0, scr, r, lane); continue; } r -= ISQ;
        if (r < ISQ) { cvt_plain(a.in[I_WMIX], D, D, nullptr, 1.f, (bf16_t*)(ws + W_MIX), 0, scr, r, lane); continue; } r -= ISQ;
        if (r < ISQ) {
            const int k = r * 2 + (lane >> 5); const float g = a.in[I_XAN][k] * 0.0625f; const float* w = a.in[I_XWQ] + (size_t)k * D + (lane & 31) * 32; bf16_t* o = (bf16_t*)(ws + W_Q) + (size_t)k * D + (lane & 31) * 32;
#pragma unroll
            for (int q = 0; q < 4; ++q) { const f32x4 v0 = *(const f32x4*)(w + q * 8), v1 = *(const f32x4*)(w + q * 8 + 4); *(u32x4*)(o + q * 8) = pack8(v0 * g, v1 * g); }
            continue; } r -= ISQ;
        if (r < ISQ) { cvt_plain(a.in[I_XWO], D, D, nullptr, 1.f, (bf16_t*)(ws + W_O), 0, scr, r, lane); continue; } r -= ISQ;
        {
            const int gi = r >> 8, co = (r >> 4) & 15, nb = r & 15, n = nb * 64 + lane;
            const float* pm = a.in[I_PMIX] + (size_t)(gi * 128 + co * 8) * 128;
#pragma unroll
            for (int i = 0; i < 16; ++i) scr[i * 64 + lane] = pm[i * 64 + lane];
            LDS_WAIT(); asm volatile("" ::: "memory");
            float acc[8] = {0.f, 0.f, 0.f, 0.f, 0.f, 0.f, 0.f, 0.f};
            const float* wb = a.in[I_WUPB] + (size_t)(gi * 128) * 1024 + n; const float* sc = a.in[I_PSC] + gi * 128;
#pragma unroll 8
            for (int d = 0; d < 128; ++d) { const float wv = wb[(size_t)d * 1024] * sc[d];
#pragma unroll
                for (int cc = 0; cc < 8; ++cc) acc[cc] += scr[cc * 128 + d] * wv; }
            u32x4 o; o.x = pk2(acc[0], acc[1]); o.y = pk2(acc[2], acc[3]); o.z = pk2(acc[4], acc[5]); o.w = pk2(acc[6], acc[7]);
            *(u32x4*)((bf16_t*)(ws + W_PB) + (size_t)n * 512 + gi * 128 + co * 8) = o;
            LDS_WAIT(); asm volatile("" ::: "memory");
        }
    }
}
__device__ __forceinline__ void prep_late(const Args& a, LAS unsigned char* lds) {
    const int tid = threadIdx.x, lane = tid & 63, wave = __builtin_amdgcn_readfirstlane(tid >> 6);
    LAS float* scr = (LAS float*)(lds + wave * 16384);
    for (int it = blockIdx.x * 8 + wave; it < PI13 + PI2; it += gridDim.x * 8) {
        if (it < PI13) cvt_w13(a.in[I_F2W1], a.in[I_F2W3], a.in[I_F2N], (bf16_t*)(a.ws + W_1C2), scr, it, lane);
        else cvt_plain(a.in[I_F2W2], FF, D, nullptr, 1.f, (bf16_t*)(a.ws + W_22), 0, scr, it - PI13, lane);
    }
}
__device__ __forceinline__ void phase_prep_rows(const Args& a) {
    const int tid = threadIdx.x, lane = tid & 63, wave = __builtin_amdgcn_readfirstlane(tid >> 6);
    const int gw = blockIdx.x * 8 + wave, NGW = gridDim.x * 8;
    unsigned char* ws = a.ws;
    for (int m0 = gw; m0 < T + NBATCH * MEMLEN; m0 += 2 * NGW) {
        f32x4 v[2][4]; float s[2];
#pragma unroll
        for (int q = 0; q < 2; ++q) { const int m = m0 + q * NGW; const bool ok = m < T + NBATCH * MEMLEN; const bool isx = m < T; const int r = isx ? m : m - T;
            const f32x4* xr = (const f32x4*)((isx ? a.in[I_X] : a.in[I_MEM]) + (size_t)(ok ? r : 0) * D) + lane;
#pragma unroll
            for (int j = 0; j < 4; ++j) v[q][j] = xr[64 * j]; }
#pragma unroll
        for (int q = 0; q < 2; ++q) { const int m = m0 + q * NGW; if (m >= T + NBATCH * MEMLEN) continue; const bool isx = m < T; const int r = isx ? m : m - T;
            float ss = 0.f;
#pragma unroll
            for (int j = 0; j < 4; ++j) ss += (v[q][j][0] * v[q][j][0] + v[q][j][1] * v[q][j][1]) + (v[q][j][2] * v[q][j][2] + v[q][j][3] * v[q][j][3]);
            ss = wave_sum(ss); s[q] = ss;
            float sc = 1.f;
            if (isx) { if (lane < 16) ((float*)(ws + WS_SSQ))[(size_t)r * 16 + lane] = lane == 0 ? ss : 0.f; }
            else sc = __builtin_amdgcn_rsqf(ss * (1.0f / D) + EPS);
            u32x2* o8 = (u32x2*)((bf16_t*)(ws + (isx ? WS_XB : WS_MB)) + (size_t)r * D) + lane;
#pragma unroll
            for (int j = 0; j < 4; ++j) { u32x2 w; w.x = pk2(v[q][j][0] * sc, v[q][j][1] * sc); w.y = pk2(v[q][j][2] * sc, v[q][j][3] * sc); o8[64 * j] = w; } }
        (void)s;
    }
}

__device__ __forceinline__ void phase_acode(const Args& a) {
    const int tid = threadIdx.x, lane = tid & 63, wave = tid >> 6, fr = lane & 15, fq = lane >> 4;
    const bf16_t* XB = (const bf16_t*)(a.ws + WS_XB); const bf16_t* WAT = (const bf16_t*)(a.ws + W_AT); const float* ssq = (const float*)(a.ws + WS_SSQ); float* AC = (float*)(a.ws + WS_ACODE);
    for (int rg = blockIdx.x * 8 + wave; rg < T / 16; rg += gridDim.x * 8) {
        const bf16_t* ap = XB + (size_t)(rg * 16 + fr) * D + fq * 8; const bf16_t* bp = WAT + (size_t)fr * D + fq * 8;
        f32x4 c = {0.f, 0.f, 0.f, 0.f};
#pragma unroll 8
        for (int kk = 0; kk < 32; ++kk) { const bf16x8 xa = *(const bf16x8*)(ap + kk * 32); const bf16x8 wb = *(const bf16x8*)(bp + kk * 32);
            c = __builtin_amdgcn_mfma_f32_16x16x32_bf16(wb, xa, c, 0, 0, 0); }
        const float r = row_rs4(ssq, rg * 16 + fr, fq);
        *(f32x4*)(AC + (size_t)(rg * 16 + fr) * 16 + 4 * fq) = c * r;
    }
}

__device__ __forceinline__ void ld8(const bf16_t* p, float* f) { const u32x4 w = *(const u32x4*)p; f[0] = bflo(w.x); f[1] = bfhi(w.x); f[2] = bflo(w.y); f[3] = bfhi(w.y); f[4] = bflo(w.z); f[5] = bfhi(w.z); f[6] = bflo(w.w); f[7] = bfhi(w.w); }
__device__ __forceinline__ void phase_pool(const Args& a) {
    const int tid = threadIdx.x, co = tid & 63, tsub = tid >> 6, gi = co >> 4, w = 2 << gi;
    const bf16_t* __restrict__ U = (const bf16_t*)(a.ws + WS_PROJ) + PU0 + co * 8; bf16_t* __restrict__ P = (bf16_t*)a.out + co * 8;
    for (int tile = blockIdx.x; tile < T / 64; tile += gridDim.x) {
        const int t0 = tile * 64 + tsub * 8, p0 = t0 & (SEQ - 1);
        float acc[8] = {0.f, 0.f, 0.f, 0.f, 0.f, 0.f, 0.f, 0.f}, f[8];
        for (int d = 1; d < w; ++d) if (p0 - d >= 0) { ld8(U + (size_t)(t0 - d) * NPROJ, f);
#pragma unroll
            for (int c = 0; c < 8; ++c) acc[c] += f[c]; }
        for (int k = 0; k < 8; ++k) {
            const int t = t0 + k, p = p0 + k; ld8(U + (size_t)t * NPROJ, f);
            const float inv = 1.0f / (float)(p + 1 < w ? p + 1 : w);
            float o[8];
#pragma unroll
            for (int c = 0; c < 8; ++c) { acc[c] += f[c]; o[c] = acc[c] * inv - f[c]; }
            u32x4 ow; ow.x = pk2(o[0], o[1]); ow.y = pk2(o[2], o[3]); ow.z = pk2(o[4], o[5]); ow.w = pk2(o[6], o[7]);
            *(u32x4*)(P + (size_t)t * 512) = ow;
            if (p - w + 1 >= 0) { float g[8]; ld8(U + (size_t)(t - w + 1) * NPROJ, g);
#pragma unroll
                for (int c = 0; c < 8; ++c) acc[c] -= g[c]; }
        }
    }
}

constexpr int GL_QT = 0, GL_KT = 17408, GL_KD = 34816, GL_VT = 53248, GL_PM = 90112, GL_TOT = 99328, GL_DL = 101376, GL_RS = 101888, GL_AC = 103936;
template <int MODE> __device__ __forceinline__ void gla_units(const Args& a, LAS unsigned char* lds) {
    const int tid = threadIdx.x, lane = tid & 63, wave = __builtin_amdgcn_readfirstlane(tid >> 6), fr = lane & 15, fq = lane >> 4;
    LAS bf16_t* QT = (LAS bf16_t*)(lds + GL_QT); LAS bf16_t* KT = (LAS bf16_t*)(lds + GL_KT); LAS bf16_t* KD = (LAS bf16_t*)(lds + GL_KD);
    LAS bf16_t* VT = (LAS bf16_t*)(lds + GL_VT); LAS bf16_t* PM = (LAS bf16_t*)(lds + GL_PM);
    LAS float* TOT = (LAS float*)(lds + GL_TOT); LAS float* DL = (LAS float*)(lds + GL_DL); LAS float* RS = (LAS float*)(lds + GL_RS); LAS float* ACL = (LAS float*)(lds + GL_AC);
    bf16_t* PROJ = (bf16_t*)(a.ws + WS_PROJ); const float* AC = (const float*)(a.ws + WS_ACODE);
    bf16_t* STG = (bf16_t*)((char*)a.out + 32 * MiB); float* LDG = (float*)(a.ws + WS_LDG);
    const int dk = tid & 127, pg = wave >> 1;
    const int dv = tid & 255, ph = wave >> 2;
    for (int unit = blockIdx.x; unit < 512; unit += gridDim.x) {
        const int bh = unit >> 4, g = unit & 15, b = bh >> 2, h = bh & 3;
        const size_t row0 = (size_t)b * SEQ + g * 256;
        float wal[16];
#pragma unroll
        for (int j = 0; j < 16; ++j) wal[j] = a.in[I_WAL][j * 512 + h * 128 + dk];
        const float bal = a.in[I_BAL][h * 128 + dk];
        f32x4 st[8][2];
        if (MODE == 1) {
            const u32x2* sp = (const u32x2*)(STG + (size_t)unit * 32768) + (wave * 16) * 64 + lane;
#pragma unroll
            for (int tk = 0; tk < 8; ++tk)
#pragma unroll
                for (int tv = 0; tv < 2; ++tv) { const u32x2 w = sp[(tk * 2 + tv) * 64]; st[tk][tv] = (f32x4){bflo(w.x), bfhi(w.x), bflo(w.y), bfhi(w.y)}; }
        } else {
#pragma unroll
            for (int tk = 0; tk < 8; ++tk)
#pragma unroll
                for (int tv = 0; tv < 2; ++tv) st[tk][tv] = (f32x4){0.f, 0.f, 0.f, 0.f};
        }
        float lsum = 0.f;
        {
            const f32x4* src = (const f32x4*)(AC + row0 * 16); LAS f32x4* dst = (LAS f32x4*)ACL;
            dst[tid] = src[tid]; dst[tid + 512] = src[tid + 512];
        }
        for (int c = 0; c < 4; ++c) {
            const size_t rowc = row0 + c * 64;
            unsigned short vraw[32];
            { const bf16_t* vp = PROJ + (rowc + ph * 32) * NPROJ + PV0 + h * 256 + dv;
#pragma unroll
              for (int i = 0; i < 32; ++i) vraw[i] = vp[(size_t)i * NPROJ]; }
            unsigned short qraw[16], kraw[16];
            { const bf16_t* qp = PROJ + (rowc + pg * 16) * NPROJ + PQ0 + h * 128 + dk;
#pragma unroll
              for (int i = 0; i < 16; ++i) { qraw[i] = qp[(size_t)i * NPROJ]; kraw[i] = qp[(size_t)i * NPROJ + (PK0 - PQ0)]; } }
            float bl[16]; float run = 0.f;
            if (c == 0) { LDS_WAIT(); __builtin_amdgcn_s_barrier(); asm volatile("" ::: "memory"); }
            { const LAS f32x4* acp = (const LAS f32x4*)(ACL + (c * 64 + pg * 16) * 16);
#pragma unroll
              for (int i = 0; i < 16; ++i) { const f32x4 c0 = acp[i * 4 + 0], c1 = acp[i * 4 + 1], c2 = acp[i * 4 + 2], c3 = acp[i * 4 + 3];
                  float z = bal;
                  z += c0[0] * wal[0] + c0[1] * wal[1] + c0[2] * wal[2] + c0[3] * wal[3]; z += c1[0] * wal[4] + c1[1] * wal[5] + c1[2] * wal[6] + c1[3] * wal[7];
                  z += c2[0] * wal[8] + c2[1] * wal[9] + c2[2] * wal[10] + c2[3] * wal[11]; z += c3[0] * wal[12] + c3[1] * wal[13] + c3[2] * wal[14] + c3[3] * wal[15];
                  const float ls = fminf(z, 0.f) - __logf(1.f + __expf(-fabsf(z)));
                  run += ls * 0.0625f; bl[i] = run; } }
            TOT[pg * 128 + dk] = run;
            LDS_WAIT(); __builtin_amdgcn_s_barrier(); asm volatile("" ::: "memory");
            const float t0 = TOT[dk], t1 = TOT[128 + dk], t2 = TOT[256 + dk], t3 = TOT[384 + dk];
            const float offs = pg == 0 ? 0.f : pg == 1 ? t0 : pg == 2 ? t0 + t1 : (t0 + t1) + t2;
            const float blast = ((t0 + t1) + t2) + t3;
            lsum += blast;
            { unsigned kd[8];
#pragma unroll
              for (int i = 0; i < 16; ++i) { const float bc = offs + bl[i]; const float eq = __expf(bc), ek = __builtin_amdgcn_rcpf(eq);
                  const int pos = pg * 16 + i;
                  if (MODE == 1) QT[pos * 136 + dk] = (bf16_t)f2bf(bf2f(qraw[i]) * 0.08838834764831845f * eq);
                  const unsigned kt = f2bf(bf2f(kraw[i]) * ek);
                  if (MODE == 1) KT[pos * 136 + dk] = (bf16_t)kt;
                  if (i & 1) kd[i >> 1] |= kt << 16; else kd[i >> 1] = kt; }
              *(LAS u32x4*)(KD + dk * 72 + pg * 16) = (u32x4){kd[0], kd[1], kd[2], kd[3]};
              *(LAS u32x4*)(KD + dk * 72 + pg * 16 + 8) = (u32x4){kd[4], kd[5], kd[6], kd[7]}; }
            if (pg == 0) DL[dk] = __expf(blast);
            {
#pragma unroll
              for (int q = 0; q < 4; ++q) { u32x4 w; w.x = vraw[q * 8 + 0] | ((unsigned)vraw[q * 8 + 1] << 16); w.y = vraw[q * 8 + 2] | ((unsigned)vraw[q * 8 + 3] << 16);
                  w.z = vraw[q * 8 + 4] | ((unsigned)vraw[q * 8 + 5] << 16); w.w = vraw[q * 8 + 6] | ((unsigned)vraw[q * 8 + 7] << 16);
                  *(LAS u32x4*)(VT + dv * 72 + ph * 32 + q * 8) = w; } }
            LDS_WAIT(); __builtin_amdgcn_s_barrier(); asm volatile("" ::: "memory");
            if (MODE == 1) {
                { const int ti = wave >> 1;
#pragma unroll
                  for (int jj = 0; jj < 2; ++jj) { const int tj = (wave & 1) * 2 + jj; f32x4 s = {0.f, 0.f, 0.f, 0.f};
                      if (tj <= ti) {
#pragma unroll
                          for (int kk = 0; kk < 4; ++kk) { const bf16x8 kf = *(const LAS bf16x8*)(KT + (tj * 16 + fr) * 136 + kk * 32 + fq * 8); const bf16x8 qf = *(const LAS bf16x8*)(QT + (ti * 16 + fr) * 136 + kk * 32 + fq * 8);
                              s = __builtin_amdgcn_mfma_f32_16x16x32_bf16(kf, qf, s, 0, 0, 0); } }
                      const int i = ti * 16 + fr, j0 = tj * 16 + fq * 4;
                      u32x2 w; w.x = pk2m(j0 + 0 <= i ? s[0] : 0.f, j0 + 1 <= i ? s[1] : 0.f); w.y = pk2m(j0 + 2 <= i ? s[2] : 0.f, j0 + 3 <= i ? s[3] : 0.f);
                      *(LAS u32x2*)(PM + i * 72 + j0) = w; } }
                LDS_WAIT(); __builtin_amdgcn_s_barrier(); asm volatile("" ::: "memory");
                f32x4 oa[2][4];
#pragma unroll
                for (int tv = 0; tv < 2; ++tv)
#pragma unroll
                    for (int ti = 0; ti < 4; ++ti) { f32x4 o = {0.f, 0.f, 0.f, 0.f};
#pragma unroll
                        for (int kk = 0; kk < 2; ++kk) { if (kk * 32 > ti * 16 + 15) continue;
                            const bf16x8 vf = *(const LAS bf16x8*)(VT + (wave * 32 + tv * 16 + fr) * 72 + kk * 32 + fq * 8); const bf16x8 pf = *(const LAS bf16x8*)(PM + (ti * 16 + fr) * 72 + kk * 32 + fq * 8);
                            o = __builtin_amdgcn_mfma_f32_16x16x32_bf16(vf, pf, o, 0, 0, 0); }
#pragma unroll
                        for (int tp = 0; tp < 4; ++tp) {
                            const f32x4 s0 = st[2 * tp][tv], s1 = st[2 * tp + 1][tv]; u32x4 sw; sw.x = pk2m(s0[0], s0[1]); sw.y = pk2m(s0[2], s0[3]); sw.z = pk2m(s1[0], s1[1]); sw.w = pk2m(s1[2], s1[3]);
                            const u32x2 q0 = *(const LAS u32x2*)(QT + (ti * 16 + fr) * 136 + tp * 32 + fq * 4), q1 = *(const LAS u32x2*)(QT + (ti * 16 + fr) * 136 + tp * 32 + 16 + fq * 4);
                            const u32x4 qw = {q0.x, q0.y, q1.x, q1.y};
                            o = __builtin_amdgcn_mfma_f32_16x16x32_bf16(__builtin_bit_cast(bf16x8, sw), __builtin_bit_cast(bf16x8, qw), o, 0, 0, 0); }
                        oa[tv][ti] = o; }
                u32x2 rwv[4][2]; f32x4 gnv[2];
#pragma unroll
                for (int tv = 0; tv < 2; ++tv) gnv[tv] = *(const f32x4*)(a.in[I_GHN] + wave * 32 + tv * 16 + fq * 4);
#pragma unroll
                for (int ti = 0; ti < 4; ++ti)
#pragma unroll
                    for (int tv = 0; tv < 2; ++tv) rwv[ti][tv] = *(const u32x2*)(PROJ + (rowc + ti * 16 + fr) * NPROJ + PR0 + h * 256 + wave * 32 + tv * 16 + fq * 4);
#pragma unroll
                for (int ti = 0; ti < 4; ++ti) { float ss = 0.f;
#pragma unroll
                    for (int tv = 0; tv < 2; ++tv) { const f32x4 o = oa[tv][ti]; ss += (o[0] * o[0] + o[1] * o[1]) + (o[2] * o[2] + o[3] * o[3]); }
                    ss += __shfl_xor(ss, 16); ss += __shfl_xor(ss, 32);
                    if (fq == 0) RS[wave * 64 + ti * 16 + fr] = ss; }
                LDS_WAIT(); __builtin_amdgcn_s_barrier(); asm volatile("" ::: "memory");
#pragma unroll
                for (int ti = 0; ti < 4; ++ti) { const int i = ti * 16 + fr; float ss = 0.f;
#pragma unroll
                    for (int w8 = 0; w8 < 8; ++w8) ss += RS[w8 * 64 + i];
                    const float rn = __builtin_amdgcn_rsqf(ss * (1.0f / 256.0f) + EPS);
#pragma unroll
                    for (int tv = 0; tv < 2; ++tv) { const int v0 = wave * 32 + tv * 16 + fq * 4;
                        const f32x4 gn = gnv[tv];
                        bf16_t* pr = PROJ + (rowc + i) * NPROJ + h * 256 + v0; const u32x2 rw = rwv[ti][tv];
                        const f32x4 o = oa[tv][ti]; u32x2 w;
                        w.x = pk2m(o[0] * rn * gn[0] * siluf_(bflo(rw.x)), o[1] * rn * gn[1] * siluf_(bfhi(rw.x)));
                        w.y = pk2m(o[2] * rn * gn[2] * siluf_(bflo(rw.y)), o[3] * rn * gn[3] * siluf_(bfhi(rw.y)));
                        *(u32x2*)(pr + PV0) = w; } }
            }
            if (MODE == 0 || c < 3) {
#pragma unroll
                for (int tk = 0; tk < 8; ++tk) { const f32x4 dd = *(const LAS f32x4*)(DL + tk * 16 + fq * 4);
#pragma unroll
                    for (int tv = 0; tv < 2; ++tv) { f32x4 s = st[tk][tv];
#pragma unroll
                        for (int kk = 0; kk < 2; ++kk) { const bf16x8 kf = *(const LAS bf16x8*)(KD + (tk * 16 + fr) * 72 + kk * 32 + fq * 8); const bf16x8 vf = *(const LAS bf16x8*)(VT + (wave * 32 + tv * 16 + fr) * 72 + kk * 32 + fq * 8);
                            s = __builtin_amdgcn_mfma_f32_16x16x32_bf16(kf, vf, s, 0, 0, 0); }
                        st[tk][tv] = s * dd; } }
            }
        }
        if (MODE == 0) {
            u32x2* sp = (u32x2*)(STG + (size_t)unit * 32768) + (wave * 16) * 64 + lane;
#pragma unroll
            for (int tk = 0; tk < 8; ++tk)
#pragma unroll
                for (int tv = 0; tv < 2; ++tv) { const f32x4 s = st[tk][tv]; u32x2 w; w.x = pk2m(s[0], s[1]); w.y = pk2m(s[2], s[3]); sp[(tk * 2 + tv) * 64] = w; }
            if (pg == 0) LDG[unit * 128 + dk] = lsum;
        }
    }
    LDS_WAIT(); __syncthreads();
}
__device__ __forceinline__ void phase_gla_scan(const Args& a) {
    bf16_t* STG = (bf16_t*)((char*)a.out + 32 * MiB); const float* LDG = (const float*)(a.ws + WS_LDG);
    for (int e = blockIdx.x * 512 + threadIdx.x; e < 32 * 8192; e += gridDim.x * 512) {
        const int bh = e >> 13, slot = e & 8191, lane = slot & 63, tl = (slot >> 6) & 15, k0 = (tl >> 1) * 16 + (lane >> 4) * 4;
        u32x2* p = (u32x2*)(STG + (size_t)bh * 16 * 32768) + slot;
        u32x2 uu[16];
#pragma unroll
        for (int g = 0; g < 16; ++g) uu[g] = p[(size_t)g * 8192];
        f32x4 s = {0.f, 0.f, 0.f, 0.f};
#pragma unroll
        for (int g = 0; g < 16; ++g) {
            u32x2 w; w.x = pk2(s[0], s[1]); w.y = pk2(s[2], s[3]); p[(size_t)g * 8192] = w;
            const f32x4 ld = *(const f32x4*)(LDG + (bh * 16 + g) * 128 + k0);
            s[0] = __expf(ld[0]) * s[0] + bflo(uu[g].x); s[1] = __expf(ld[1]) * s[1] + bfhi(uu[g].x);
            s[2] = __expf(ld[2]) * s[2] + bflo(uu[g].y); s[3] = __expf(ld[3]) * s[3] + bfhi(uu[g].y);
        }
    }
}
__device__ __forceinline__ void phase_final(const Args& a) {
    const int lane = threadIdx.x & 63, wave = threadIdx.x >> 6; const float* __restrict__ ssq = (const float*)(a.ws + WS_SSQ); const bf16_t* __restrict__ XB = (const bf16_t*)(a.ws + WS_XB);
    float* __restrict__ out = a.out; const f32x4* gp = (const f32x4*)a.in[I_FN] + 2 * lane;
    const f32x4 g00 = gp[0], g01 = gp[1], g10 = gp[128], g11 = gp[129];
    const int NW = gridDim.x * 8;
    for (int m0 = blockIdx.x * 8 + wave; m0 < T; m0 += 4 * NW) {
        u32x4 b[4][2]; float r[4];
#pragma unroll
        for (int q = 0; q < 4; ++q) { const int m = m0 + q * NW < T ? m0 + q * NW : m0; const u32x4* xr = (const u32x4*)(XB + (size_t)m * D) + lane; b[q][0] = xr[0]; b[q][1] = xr[64]; r[q] = row_rs(ssq, m); }
#pragma unroll
        for (int q = 0; q < 4; ++q) { const int m = m0 + q * NW; if (m >= T) continue; f32x4* orow = (f32x4*)(out + (size_t)m * D) + 2 * lane;
#pragma unroll
            for (int j = 0; j < 2; ++j) { const u32x4 w = b[q][j]; f32x4 o0, o1; o0[0] = bflo(w.x); o0[1] = bfhi(w.x); o0[2] = bflo(w.y); o0[3] = bfhi(w.y); o1[0] = bflo(w.z); o1[1] = bfhi(w.z); o1[2] = bflo(w.w); o1[3] = bfhi(w.w);
                orow[128 * j] = o0 * r[q] * (j ? g10 : g00); orow[128 * j + 1] = o1 * r[q] * (j ? g11 : g01); } }
    }
}

#define XB_TMO      128
#define XB_XCNT(j)  (256  + 64 * (j))
#define XB_XSUB(j)  (1280 + 64 * (j))
#define XB_XGEN(j)  (2304 + 64 * (j))
#define XB_TOP      3328
#define XB_TOPGEN   3392
#define XCD_BAR_WORDS 3456
#define XB_SPIN_CAP (1u << 22)
__device__ __forceinline__ unsigned xb_ld(unsigned* p)              { return __hip_atomic_load(p, __ATOMIC_RELAXED, __HIP_MEMORY_SCOPE_AGENT); }
__device__ __forceinline__ unsigned xb_add(unsigned* p, unsigned v) { return __hip_atomic_fetch_add(p, v, __ATOMIC_RELAXED, __HIP_MEMORY_SCOPE_AGENT); }
__device__ __forceinline__ unsigned xb_xcc_id() { return (unsigned)__builtin_amdgcn_s_getreg((3 << 11) | 20) & 0xFu; }
#define XB_SPIN(cond, bar) do { unsigned _sp = 0; while (cond) { __builtin_amdgcn_s_sleep(1); \
    if ((++_sp & 255u) == 0u) { if (xb_ld(&(bar)[XB_TMO])) break; if (_sp > XB_SPIN_CAP) { atomicAdd(&(bar)[XB_TMO], 1u); break; } } } } while (0)
struct XcdBarrier { unsigned* bar; unsigned x; volatile LAS unsigned* st; };
__device__ __forceinline__ XcdBarrier xcd_barrier_post(unsigned* bar, volatile LAS unsigned* st) {
    XcdBarrier b; b.bar = bar; b.x = xb_xcc_id(); b.st = st;
    if (threadIdx.x == 0) (void)xb_add(&bar[XB_XCNT(b.x)], 1u);
    return b;
}
__device__ __forceinline__ void xcd_barrier_complete(unsigned* bar, unsigned x, unsigned& nloc, unsigned& nx);
__device__ __forceinline__ void xcd_barrier_census(const XcdBarrier& b) {
    if (threadIdx.x == 0) { unsigned nloc, nx; xcd_barrier_complete(b.bar, b.x, nloc, nx); b.st[0] = nloc; b.st[1] = nx; }
    __syncthreads();
}
__device__ __forceinline__ void xcd_barrier_complete(unsigned* bar, unsigned x, unsigned& nloc, unsigned& nx) {
    const unsigned G = gridDim.x * gridDim.y * gridDim.z;
    unsigned sum, cnt, mine, sp = 0u;
    for (;;) {
        sum = 0u; cnt = 0u; mine = 0u;
#pragma unroll
        for (unsigned j = 0; j < 16; ++j) { const unsigned c = xb_ld(&bar[XB_XCNT(j)]); sum += c; cnt += (c > 0u) ? 1u : 0u; mine = (j == x) ? c : mine; }
        if (sum == G) break;
        __builtin_amdgcn_s_sleep(1);
        if ((++sp & 255u) == 0u) { if (xb_ld(&bar[XB_TMO])) break; if (sp > XB_SPIN_CAP) { atomicAdd(&bar[XB_TMO], 1u); break; } }
    }
    nloc = mine > 0u ? mine : 1u; nx = cnt > 0u ? cnt : 1u;
}
__device__ __forceinline__ void xcd_barrier(const XcdBarrier& b) {
    asm volatile("s_waitcnt vmcnt(0)" ::: "memory");
    __syncthreads();
    if (threadIdx.x == 0) {
        unsigned* bar = b.bar;
        __builtin_amdgcn_s_waitcnt(0);
        const unsigned nloc = b.st[0], nx = b.st[1];
        const unsigned old = xb_add(&bar[XB_XSUB(b.x)], 1u);
        const unsigned gen = old / nloc;
        if (old + 1u == (gen + 1u) * nloc) {
            __builtin_amdgcn_fence(__ATOMIC_RELEASE, "agent");
            asm volatile("s_waitcnt vmcnt(0)" ::: "memory");
            const unsigned og = xb_add(&bar[XB_TOP], 1u);
            const unsigned tg = og / nx;
            if (og + 1u == (tg + 1u) * nx) xb_add(&bar[XB_TOPGEN], 1u);
            else XB_SPIN(xb_ld(&bar[XB_TOPGEN]) == tg, bar);
            __builtin_amdgcn_fence(__ATOMIC_ACQUIRE, "agent");
            xb_add(&bar[XB_XGEN(b.x)], 1u);
            asm volatile("s_waitcnt vmcnt(0)" ::: "memory");
        } else {
            XB_SPIN(xb_ld(&bar[XB_XGEN(b.x)]) == gen, bar);
            __builtin_amdgcn_fence(__ATOMIC_ACQUIRE, "agent");
            asm volatile("s_waitcnt vmcnt(0)" ::: "memory");
        }
    }
    __syncthreads();
}

__global__ void __launch_bounds__(512, 2) hybrid_fwd(Args args) {
    extern __shared__ __attribute__((aligned(16))) unsigned char lds_raw[];
    LAS unsigned char* lds = (LAS unsigned char*)lds_raw;
    cg::grid_group grid = cg::this_grid();
    unsigned char* ws = args.ws;
    const int lo = args.ph_lo, hi = args.ph_hi, G = gridDim.x, c = blockIdx.x;
    const char* XB = (const char*)(ws + WS_XB); bf16_t* PROJ = (bf16_t*)(ws + WS_PROJ); float* SSQ = (float*)(ws + WS_SSQ);
#ifndef PH_MASK
#define PH_MASK 0xffff
#endif
#define IN(k) (((PH_MASK >> (k)) & 1) && lo <= (k) && (k) < hi)
    volatile LAS unsigned* bst = (volatile LAS unsigned*)(lds + EPI_LDS_OFF + 8192);
    if (threadIdx.x < 2) bst[threadIdx.x] = 0u;
    __syncthreads();
    XcdBarrier xbar; xbar.bar = (unsigned*)(ws + WS_CTL); xbar.x = 0; xbar.st = bst;
    if (hi - lo > 1) { xbar = xcd_barrier_post((unsigned*)(ws + WS_CTL), bst); grid.sync(); xcd_barrier_census(xbar); }
#define SEAM(k) do { if (IN(k) && IN((k) + 1)) { xcd_barrier(xbar); } } while (0)
    const int GC = G >= 64 ? G - 16 : G;
    {
        int npass = 2; asm volatile("" : "+s"(npass));
#pragma nounroll
        for (int pass = 0; pass < npass; ++pass) {
            const bool run = pass == 0 ? IN(0) : (IN(1) && (c >= GC || GC == G));
            if (run) { const int wv = threadIdx.x >> 6;
                prep_items(args, lds, pass ? PREP_EARLY : 0, pass ? PREP_NITEMS : PREP_EARLY, pass && GC != G ? (c - GC) * 8 + wv : c * 8 + wv, pass && GC != G ? (G - GC) * 8 : G * 8); __syncthreads(); }
            if (pass == 0) { if (IN(0)) phase_prep_rows(args); SEAM(0); }
        }
    }
    if (IN(1)) {
        SchedUpKV S; S.o.init(T / 256, 5632 / 256, GC, c); S.ws = (const char*)ws; S.offA = WS_XB; S.offB = W_1C1;
        EpiSwiGLU E{(bf16_t*)(ws + WS_H), SSQ, (bf16_t*)(ws + WS_KV)};
        if (c < GC || GC == G) pg8::gemm_phase(lds, 1024, 1024, 1024, S, E);
    } SEAM(1);
    if (IN(2)) {
        SchedPlain S; S.o.init(T / 256, 4, G, c); S.A = (const char*)(ws + WS_H); S.B = (const char*)(ws + W_21); S.ta = (size_t)256 * FF * 2; S.tb = (size_t)256 * FF * 2;
        EpiResid E{(bf16_t*)(ws + WS_XB), SSQ, 0.5f};
        pg8::gemm_phase(lds, FF, FF, FF, S, E);
    } SEAM(2);
    if (IN(3)) {
        SchedPlain S; S.o.init(T / 256, NPROJ / 256, G, c); S.A = XB; S.B = (const char*)(ws + W_IN); S.ta = (size_t)256 * 1024 * 2; S.tb = (size_t)256 * 1024 * 2;
        EpiScaleBf16<true> E{PROJ, NPROJ, SSQ};
        pg8::gemm_phase(lds, 1024, 1024, 1024, S, E);
        phase_acode(args);
    } SEAM(3);
    if (IN(4)) { gla_units<0>(args, lds); phase_pool(args); prep_late(args, lds); } SEAM(4);
    if (IN(5)) {
        phase_gla_scan(args);
        SchedPlain S; S.o.init(T / 256, 4, G, c); S.A = (const char*)args.out; S.B = (const char*)(ws + W_PB); S.ta = (size_t)256 * 512 * 2; S.tb = (size_t)256 * 512 * 2;
        EpiYB E{PROJ};
        pg8::gemm_phase(lds, 512, 512, 512, S, E);
        {
            SchedPre P; P.G = G; P.c = c; P.mode = 0; P.KV = (const char*)(ws + WS_KV); P.W = (const char*)(ws + W_Q);
            EpiPre EP{(bf16_t*)(ws + WS_WQK), 0};
            pg8::gemm_phase(lds, 256, 2048, 1024, P, EP);
        }
        {
            SchedPre P; P.G = G; P.c = (c + G / 2) % G; P.mode = 1; P.KV = (const char*)(ws + WS_KV); P.W = (const char*)(ws + W_O);
            EpiPre EP{(bf16_t*)(ws + WS_VWOT), 1};
            pg8::gemm_phase(lds, 256, 1024, 2048, P, EP);
        }
    } SEAM(5);
    if (IN(6)) { gla_units<1>(args, lds); } SEAM(6);
    if (IN(7)) {
        SchedPlain S; S.o.init(T / 256, 4, G, c); S.A = (const char*)(PROJ + PV0); S.B = (const char*)(ws + W_UPA); S.ta = (size_t)256 * NPROJ * 2; S.tb = (size_t)256 * 1024 * 2;
        EpiMG E{PROJ};
        pg8::gemm_phase(lds, 1024, NPROJ, 1024, S, E);
    } SEAM(7);
    if (IN(8)) {
        SchedPlain S; S.o.init(T / 256, 4, G, c); S.A = (const char*)(PROJ + PGA0); S.B = (const char*)(ws + W_MIX); S.ta = (size_t)256 * NPROJ * 2; S.tb = (size_t)256 * 1024 * 2;
        EpiResid E{(bf16_t*)(ws + WS_XB), SSQ, 1.0f};
        pg8::gemm_phase(lds, 1024, NPROJ, 1024, S, E);
    } SEAM(8);
    if (IN(9)) {
        SchedAttn S; S.G = G; S.c = c; S.A = XB; S.B = (const char*)(ws + WS_WQK);
        EpiSoftmax E{(bf16_t*)(ws + WS_PR), (LAS float*)(lds + EPI_LDS_OFF), SSQ};
        pg8::gemm_phase(lds, 1024, 1024, 1024, S, E);
    } SEAM(9);
    if (IN(10)) {
        SchedAttn S; S.G = G; S.c = c; S.A = (const char*)(ws + WS_PR); S.B = (const char*)(ws + WS_VWOT);
        EpiResid E{(bf16_t*)(ws + WS_XB), SSQ, 1.0f};
        pg8::gemm_phase(lds, 1024, 1024, 1024, S, E);
    } SEAM(10);
    if (IN(11)) {
        SchedPlain S2; S2.o.init(T / 256, 5632 / 256, G, c); S2.A = XB; S2.B = (const char*)(ws + W_1C2); S2.ta = (size_t)256 * 1024 * 2; S2.tb = (size_t)256 * 1024 * 2;
        EpiSwiGLU E{(bf16_t*)(ws + WS_H), SSQ, nullptr};
        pg8::gemm_phase(lds, 1024, 1024, 1024, S2, E);
    } SEAM(11);
    if (IN(12)) {
        SchedPlain S; S.o.init(T / 256, 4, G, c); S.A = (const char*)(ws + WS_H); S.B = (const char*)(ws + W_22); S.ta = (size_t)256 * FF * 2; S.tb = (size_t)256 * FF * 2;
        EpiResid E{(bf16_t*)(ws + WS_XB), SSQ, 0.5f};
        pg8::gemm_phase(lds, FF, FF, FF, S, E);
    } SEAM(12);
    if (IN(13)) { phase_final(args); }
#undef IN
#undef SEAM
}

extern "C" void kernel_launch(void* const* d_in, const int* in_sizes, int n_in, void* d_out, int out_size, void* d_ws, size_t ws_size, hipStream_t stream) {
    static int grid = 0;
    if (grid == 0) {
        if (n_in != 27 || out_size != T * D || ws_size < WS_VWOT + 16 * MiB) { fprintf(stderr, "kernel_launch: unexpected problem (n_in %d out %d ws %zu, need ws >= %zu)\n", n_in, out_size, ws_size, (size_t)(WS_VWOT + 16 * MiB)); grid = -1; return; }
        int dev = 0, cus = 0, per_cu = 0;
        (void)hipGetDevice(&dev); (void)hipDeviceGetAttribute(&cus, hipDeviceAttributeMultiprocessorCount, dev);
        if (hipFuncSetAttribute((const void*)hybrid_fwd, hipFuncAttributeMaxDynamicSharedMemorySize, LDS_BYTES) != hipSuccess) { fprintf(stderr, "kernel_launch: hipFuncSetAttribute failed\n"); grid = -1; return; }
        (void)hipOccupancyMaxActiveBlocksPerMultiprocessor(&per_cu, (const void*)hybrid_fwd, 512, LDS_BYTES);
        (void)hipGetLastError();
        if (per_cu < 1) per_cu = 1;
        grid = cus * per_cu;
    }
    if (grid < 0) return;
    Args a{};
    for (int i = 0; i < 27; ++i) a.in[i] = (const float*)d_in[i];
    a.out = (float*)d_out; a.ws = (unsigned char*)d_ws;
#if MK_ONE_LAUNCH
    a.ph_lo = 0; a.ph_hi = NPHASE;
    if (hipMemsetAsync((char*)d_ws + WS_CTL, 0, CTL_BYTES, stream) != hipSuccess) { fprintf(stderr, "kernel_launch: memset of the barrier words failed\n"); return; }
    void* kargs[] = {&a};
    hipError_t e = hipLaunchCooperativeKernel((const void*)hybrid_fwd, dim3(grid), dim3(512), kargs, LDS_BYTES, stream);
    if (e != hipSuccess) fprintf(stderr, "cooperative launch failed: %s (grid %d)\n", hipGetErrorString(e), grid);
#else
    for (int p = 0; p < NPHASE; ++p) { a.ph_lo = p; a.ph_hi = p + 1; hipLaunchKernelGGL(hybrid_fwd, dim3(grid), dim3(512), LDS_BYTES, stream, a); }
#endif
}
```

```cpp
#include <hip/hip_runtime.h>
#include <hip/hip_cooperative_groups.h>
#include <cstdio>
#include <cstdint>
namespace cg = cooperative_groups;

#ifndef MK_ONE_LAUNCH
#define MK_ONE_LAUNCH 1
#endif

#define LAS __attribute__((address_space(3)))
typedef unsigned short bf16_t;
typedef short bf16x8 __attribute__((ext_vector_type(8)));
typedef short bf16x4 __attribute__((ext_vector_type(4)));
typedef float f32x4 __attribute__((ext_vector_type(4)));
typedef float f32x2 __attribute__((ext_vector_type(2)));
typedef unsigned u32x4 __attribute__((ext_vector_type(4)));
typedef unsigned u32x2 __attribute__((ext_vector_type(2)));

constexpr int T = 32768, D = 1024, FF = 2816, SEQ = 4096, NBATCH = 8, MEMLEN = 256;
constexpr int NPROJ = 5632;
constexpr int PQ0 = 0, PK0 = 512, PV0 = 1024, PR0 = 2048, PU0 = 3072, PGA0 = 3584, PGB0 = 4608;
constexpr int WIN_LD = 5648;
constexpr float EPS = 1e-6f;
constexpr int NPHASE = 14;

constexpr size_t MiB = 1u << 20;
constexpr size_t WS_SSQ = 0, WS_ACODE = 2 * MiB, WS_LDG = 4 * MiB, WS_KV = 5 * MiB, WS_MB = 13 * MiB;
constexpr size_t WS_CTL = 18 * MiB, CTL_BYTES = 16384;
constexpr size_t WS_W = 20 * MiB;
constexpr size_t W_1C1 = WS_W, W_21 = W_1C1 + (size_t)5632 * 1024 * 2, W_IN = W_21 + (size_t)1024 * 2816 * 2, W_AT = W_IN + (size_t)5632 * 1024 * 2,
                 W_UPA = W_AT + 32768, W_PB = W_UPA + 2 * MiB, W_MIX = W_PB + MiB, W_Q = W_MIX + 2 * MiB, W_KV = W_Q + 2 * MiB, W_O = W_KV + 4 * MiB,
                 W_1C2 = W_O + 2 * MiB, W_22 = W_1C2 + (size_t)5632 * 1024 * 2, W_END = W_22 + (size_t)1024 * 2816 * 2;
static_assert(W_END <= 80 * MiB && W_IN >= W_1C1 + 16 * MiB, "weight region");
constexpr size_t WS_XB = 80 * MiB, WS_PB = 80 * MiB, WS_STG = 112 * MiB;
constexpr size_t WS_PROJ = 144 * MiB, WS_H = WS_PROJ, WS_PR = WS_PROJ + 64 * MiB;
constexpr size_t WS_VWOT = 496 * MiB;
constexpr size_t WS_WQK = W_1C1;
constexpr size_t WS_END = WS_PROJ + (size_t)T * NPROJ * 2;
static_assert(WS_END <= 512 * MiB, "d_ws map");

constexpr int RING_BYTES = 131072, EPI_LDS_OFF = RING_BYTES, LDS_BYTES = 147456;

__device__ __forceinline__ unsigned f2bf(float f) { unsigned u = __builtin_bit_cast(unsigned, f); return (u + 0x7fffu + ((u >> 16) & 1u)) >> 16; }
__device__ __forceinline__ unsigned pk2(float lo, float hi) { unsigned r; asm("v_cvt_pk_bf16_f32 %0, %1, %2" : "=v"(r) : "v"(lo), "v"(hi)); return r; }
__device__ __forceinline__ unsigned pk2m(float lo, float hi) { return f2bf(lo) | (f2bf(hi) << 16); }
__device__ __forceinline__ float bf2f(unsigned short b) { return __builtin_bit_cast(float, (unsigned)b << 16); }
__device__ __forceinline__ float bflo(unsigned w) { return __builtin_bit_cast(float, w << 16); }
__device__ __forceinline__ float bfhi(unsigned w) { return __builtin_bit_cast(float, w & 0xffff0000u); }
__device__ __forceinline__ float sigmoidf_(float x) { return __builtin_amdgcn_rcpf(1.f + __expf(-x)); }
__device__ __forceinline__ float siluf_(float x) { return x * sigmoidf_(x); }
__device__ __forceinline__ float wave_sum(float v) {
#pragma unroll
    for (int o = 1; o < 64; o <<= 1) v += __shfl_xor(v, o);
    return v;
}
#define LDS_WAIT() asm volatile("s_waitcnt lgkmcnt(0)" ::: "memory")

namespace pg8 {
constexpr int BM = 256, BK = 64, HALF = 128, HTB = HALF * BK * 2, NXCD = 8, WGM = 8;
__host__ __device__ __forceinline__ int lds_byte(int r, int c) { const int st = (r >> 4) * 2 + (c >> 5), rr = r & 15, cc = c & 31, ob = rr * 64 + cc * 2; return st * 1024 + (ob ^ (((ob >> 9) & 1) << 5)); }
__host__ __device__ __forceinline__ void stage_rc(int b, int& R, int& C) { const int st = b / 1024, sb = b % 1024, swz = sb ^ (((sb >> 9) & 1) << 5); R = (st >> 1) * 16 + swz / 64; C = (st & 1) * 32 + (swz % 64) / 2; }
__host__ __device__ __forceinline__ int perm32(int rho) { const int n = rho >> 4, i = rho & 15; return 8 * (i >> 2) + 4 * n + (i & 3); }

struct Unit { int pm, pn, kind; };

struct GridOrder {
    int nM, nN, nwg, G, c;
    __device__ __forceinline__ void init(int nM_, int nN_, int G_, int c_) { nM = nM_; nN = nN_; nwg = nM * nN; G = G_; c = c_; }
    __device__ __forceinline__ bool map(int L, Unit& u) const {
        if (L >= nwg) return false;
        int wgid = L; { const int q = nwg / NXCD, r = nwg % NXCD, xcd = wgid % NXCD, off = wgid / NXCD; wgid = (xcd < r ? xcd * (q + 1) : r * (q + 1) + (xcd - r) * q) + off; }
        const int nig = WGM * nN, gid = wgid / nig, fm = gid * WGM, gsz = (nM - fm) < WGM ? (nM - fm) : WGM;
        u.pm = fm + ((wgid % nig) % gsz); u.pn = (wgid % nig) / gsz; u.kind = 0; return true;
    }
};

template <class Epi, class Sched>
__device__ __forceinline__ void gemm_phase(LAS unsigned char* lds, const int K, const int lda, const int ldb, const Sched& S, const Epi& E) {
    const int tid = threadIdx.x, wid = __builtin_amdgcn_readfirstlane(tid >> 6), lane = tid & 63, wr = wid >> 2, wc = wid & 3, fr = lane & 15, fq = lane >> 4;
    int nt = K / BK; asm volatile("" : "+s"(nt));
    unsigned voffA[2], voffB[2];
#pragma unroll
    for (int i = 0; i < 2; ++i) { int R, C; stage_rc(tid * 16 + i * 8192, R, C); const int Rb = Epi::PERM ? ((R & ~31) + perm32(R & 31)) : R;
        voffA[i] = (unsigned)(R * lda + C) * 2u; voffB[i] = (unsigned)(Rb * ldb + C) * 2u; }
    const size_t kstep = (size_t)(BK * 2);
    const size_t hstepA = (size_t)HALF * lda * 2, hstepB = (size_t)HALF * ldb * 2;
    const unsigned ldsw = (unsigned)wid * 1024u;
    const int aoff = lds_byte(wr * 64 + fr, fq * 8), boff = lds_byte(wc * 32 + fr, fq * 8);
#define PG8_SA(b, h) (((b) * 2 + (h)) * HTB)
#define PG8_SB(b, h) ((4 + (b) * 2 + (h)) * HTB)
#define PG8_STAGE(bufoff, gbase, voff) do { _Pragma("unroll") for (int _i = 0; _i < 2; ++_i) \
        __builtin_amdgcn_global_load_lds((const unsigned*)((const char*)(gbase) + (voff)[_i]), (LAS unsigned*)(lds + (bufoff) + ldsw + _i * 8192), 16, 0, 0); } while (0)
#define PG8_LDA(dst, b, h) do { _Pragma("unroll") for (int m = 0; m < 4; ++m) _Pragma("unroll") for (int k = 0; k < 2; ++k) dst[m][k] = *(const LAS bf16x8*)(lds + PG8_SA(b, h) + aoff + m * 2048 + k * 1024); } while (0)
#define PG8_LDB(dst, b, h) do { _Pragma("unroll") for (int n = 0; n < 2; ++n) _Pragma("unroll") for (int k = 0; k < 2; ++k) dst[n][k] = *(const LAS bf16x8*)(lds + PG8_SB(b, h) + boff + n * 2048 + k * 1024); } while (0)
#define PG8_MMA(ai, bj, At, Bt) do { __builtin_amdgcn_s_setprio(1); _Pragma("unroll") for (int m = 0; m < 4; ++m) _Pragma("unroll") for (int n = 0; n < 2; ++n) _Pragma("unroll") for (int k = 0; k < 2; ++k) \
        acc[ai][bj][m][n] = __builtin_amdgcn_mfma_f32_16x16x32_bf16(Bt[n][k], At[m][k], acc[ai][bj][m][n], 0, 0, 0); __builtin_amdgcn_s_setprio(0); } while (0)
#define PG8_WAIT_V(n) asm volatile("s_waitcnt vmcnt(" #n ")" ::: "memory")
#define PG8_WAIT_L(n) asm volatile("s_waitcnt lgkmcnt(" #n ")" ::: "memory")
#define PG8_BAR __builtin_amdgcn_s_barrier()
#define PG8_SCHED __builtin_amdgcn_sched_barrier(0)
    Unit cur, nxt; int ui = 0;
    if (!S.next(0, cur)) return;
    f32x4 acc[2][2][4][2];
#pragma unroll
    for (int a = 0; a < 2; ++a)
#pragma unroll
        for (int b = 0; b < 2; ++b)
#pragma unroll
            for (int m = 0; m < 4; ++m)
#pragma unroll
                for (int n = 0; n < 2; ++n) acc[a][b][m][n] = (f32x4){0.f, 0.f, 0.f, 0.f};
    bf16x8 At[4][2], B0[2][2], B1[2][2];
    const char* cA = S.a(cur); const char* cB = S.b(cur);
    PG8_STAGE(PG8_SB(0, 0), cB, voffB); PG8_STAGE(PG8_SB(0, 1), cB + hstepB, voffB); PG8_STAGE(PG8_SA(0, 0), cA, voffA); PG8_STAGE(PG8_SA(0, 1), cA + hstepA, voffA);
    if (wr == 1) PG8_BAR;
    PG8_WAIT_V(2); PG8_BAR;
    PG8_STAGE(PG8_SB(1, 0), cB + kstep, voffB); PG8_STAGE(PG8_SA(1, 0), cA + kstep, voffA); PG8_STAGE(PG8_SB(1, 1), cB + hstepB + kstep, voffB);
    PG8_WAIT_V(6); PG8_BAR;
    for (;;) {
        const bool has_next = S.next(ui + 1, nxt);
        const char* nA = has_next ? S.a(nxt) : cA; const char* nB = has_next ? S.b(nxt) : cB;
        for (int t = 0; t < nt; t += 2) {
            const bool last = (t == nt - 2);
            const char* a1 = cA + (size_t)(t + 1) * kstep;
            const char* a2 = last ? nA : cA + (size_t)(t + 2) * kstep; const char* b2 = last ? nB : cB + (size_t)(t + 2) * kstep;
            const char* a3 = a2 + kstep; const char* b3 = b2 + kstep;
            PG8_LDB(B0, 0, 0); PG8_LDB(B1, 0, 1); PG8_SCHED; PG8_LDA(At, 0, 0); PG8_STAGE(PG8_SA(1, 1), a1 + hstepA, voffA);
            PG8_WAIT_V(8); PG8_WAIT_L(0); PG8_BAR; PG8_MMA(0, 0, At, B0); PG8_MMA(0, 1, At, B1); PG8_BAR; PG8_SCHED;
            PG8_LDA(At, 0, 1); PG8_STAGE(PG8_SB(0, 0), b2, voffB); PG8_STAGE(PG8_SB(0, 1), b2 + hstepB, voffB); PG8_STAGE(PG8_SA(0, 0), a2, voffA);
            PG8_WAIT_V(8); PG8_WAIT_L(0); PG8_BAR; PG8_MMA(1, 0, At, B0); PG8_MMA(1, 1, At, B1); PG8_BAR; PG8_SCHED;
            PG8_LDB(B0, 1, 0); PG8_LDB(B1, 1, 1); PG8_SCHED; PG8_LDA(At, 1, 0); PG8_STAGE(PG8_SA(0, 1), a2 + hstepA, voffA);
            PG8_WAIT_V(8); PG8_WAIT_L(0); PG8_BAR; PG8_MMA(0, 0, At, B0); PG8_MMA(0, 1, At, B1); PG8_BAR; PG8_SCHED;
            PG8_LDA(At, 1, 1); PG8_STAGE(PG8_SB(1, 0), b3, voffB); PG8_STAGE(PG8_SB(1, 1), b3 + hstepB, voffB); PG8_STAGE(PG8_SA(1, 0), a3, voffA);
            PG8_WAIT_V(8); PG8_WAIT_L(0); PG8_BAR; PG8_MMA(1, 0, At, B0); PG8_MMA(1, 1, At, B1); PG8_BAR; PG8_SCHED;
        }
        if (wr == 0) PG8_BAR;
        E(acc, cur, wr, wc, fr, fq);
        if (!has_next) break;
#pragma unroll
        for (int a = 0; a < 2; ++a)
#pragma unroll
            for (int b = 0; b < 2; ++b)
#pragma unroll
                for (int m = 0; m < 4; ++m)
#pragma unroll
                    for (int n = 0; n < 2; ++n) acc[a][b][m][n] = (f32x4){0.f, 0.f, 0.f, 0.f};
        cur = nxt; cA = nA; cB = nB; ++ui;
        if (wr == 1) PG8_BAR;
    }
    PG8_WAIT_V(0);
    PG8_BAR;
#undef PG8_SA
#undef PG8_SB
#undef PG8_STAGE
#undef PG8_LDA
#undef PG8_LDB
#undef PG8_MMA
#undef PG8_WAIT_V
#undef PG8_WAIT_L
#undef PG8_SCHED
}
}
using pg8::Unit;
typedef f32x4 Acc[2][2][4][2];

struct SchedPlain {
    pg8::GridOrder o; const char* A; const char* B; size_t ta, tb;
    __device__ __forceinline__ bool next(int i, Unit& u) const { return o.map(i * o.G + o.c, u); }
    __device__ __forceinline__ const char* a(const Unit& u) const { return A + (size_t)u.pm * ta; }
    __device__ __forceinline__ const char* b(const Unit& u) const { return B + (size_t)u.pn * tb; }
};
struct SchedUpKV {
    pg8::GridOrder o; const char* ws; size_t offA, offB;
    __device__ __forceinline__ bool next(int i, Unit& u) const { const int L = i * o.G + o.c; if (L < o.nwg) return o.map(L, u); const int r = L - o.nwg; if (r >= 64) return false;
        u.pm = r & 7; u.pn = r >> 3; u.kind = 1; return true; }
    __device__ __forceinline__ const char* a(const Unit& u) const { return ws + (u.kind == 0 ? offA : WS_MB) + (size_t)u.pm * (256 * 1024 * 2); }
    __device__ __forceinline__ const char* b(const Unit& u) const { return ws + (u.kind == 0 ? offB : W_KV) + (size_t)u.pn * (256 * 1024 * 2); }
};
struct SchedAttn {
    int G, c; const char* A; const char* B;
    __device__ __forceinline__ bool next(int i, Unit& u) const { const int L = i * G + c; if (L >= 512) return false; u.pm = L >> 2; u.pn = L & 3; u.kind = 0; return true; }
    __device__ __forceinline__ const char* a(const Unit& u) const { return A + (size_t)u.pm * (256 * 1024 * 2); }
    __device__ __forceinline__ const char* b(const Unit& u) const { return B + (size_t)(u.pm >> 4) * (2 * MiB) + (size_t)u.pn * (256 * 1024 * 2); }
};
struct SchedPre {
    int G, c, mode; const char* KV; const char* W;
    __device__ __forceinline__ bool next(int i, Unit& u) const { const int L = i * G + c; if (L >= 128) return false; u.pm = L >> 2; u.pn = L & 3; u.kind = 0; return true; }
    __device__ __forceinline__ const char* kv(const Unit& u) const { return KV + (size_t)(u.pm >> 2) * (256 * 2048 * 2) + (mode ? 2048 : 0) + (size_t)(u.pm & 3) * 512; }
    __device__ __forceinline__ const char* w(const Unit& u) const { return W + (size_t)u.pn * (256 * 1024 * 2) + (size_t)(u.pm & 3) * 512; }
    __device__ __forceinline__ const char* a(const Unit& u) const { return mode ? w(u) : kv(u); }
    __device__ __forceinline__ const char* b(const Unit& u) const { return mode ? kv(u) : w(u); }
};

__device__ __forceinline__ float row_rs(const float* ssq, int row) {
    const f32x4* p = (const f32x4*)(ssq + (size_t)row * 16);
    const f32x4 a = p[0], b = p[1], c = p[2], d = p[3];
    const float s = ((a[0] + a[1]) + (a[2] + a[3])) + ((b[0] + b[1]) + (b[2] + b[3])) + ((c[0] + c[1]) + (c[2] + c[3])) + ((d[0] + d[1]) + (d[2] + d[3]));
    return __builtin_amdgcn_rsqf(s * (1.0f / D) + EPS);
}
__device__ __forceinline__ float row_rs4(const float* ssq, int row, int fq) {
    const f32x4 a = *(const f32x4*)(ssq + (size_t)row * 16 + 4 * fq);
    float s = (a[0] + a[1]) + (a[2] + a[3]);
    s += __shfl_xor(s, 16); s += __shfl_xor(s, 32);
    return __builtin_amdgcn_rsqf(s * (1.0f / D) + EPS);
}
__device__ __forceinline__ void rows_rs(const float* ssq, int row0, int fq, float (&rr)[2][4]) {
    f32x4 p[2][4];
#pragma unroll
    for (int ai = 0; ai < 2; ++ai)
#pragma unroll
        for (int m = 0; m < 4; ++m) p[ai][m] = *(const f32x4*)(ssq + (size_t)(row0 + ai * 128 + m * 16) * 16 + 4 * fq);
    asm volatile("" ::: "memory");
#pragma unroll
    for (int ai = 0; ai < 2; ++ai)
#pragma unroll
        for (int m = 0; m < 4; ++m) { float s = (p[ai][m][0] + p[ai][m][1]) + (p[ai][m][2] + p[ai][m][3]); s += __shfl_xor(s, 16); s += __shfl_xor(s, 32); rr[ai][m] = __builtin_amdgcn_rsqf(s * (1.0f / D) + EPS); }
}
__device__ __forceinline__ u32x4 pack8(const f32x4 v0, const f32x4 v1) { u32x4 w; w.x = pk2(v0[0], v0[1]); w.y = pk2(v0[2], v0[3]); w.z = pk2(v1[0], v1[1]); w.w = pk2(v1[2], v1[3]); return w; }

struct EpiSwiGLU {
    static constexpr bool PERM = true;
    bf16_t* H; const float* ssq; bf16_t* KV;
    __device__ __forceinline__ void operator()(Acc& acc, const Unit& u, int wr, int wc, int fr, int fq) const {
        if (u.kind == 0) {
            float rr[2][4]; rows_rs(ssq, u.pm * 256 + wr * 64 + fr, fq, rr);
#pragma unroll
            for (int ai = 0; ai < 2; ++ai)
#pragma unroll
                for (int m = 0; m < 4; ++m) {
                    const int row = u.pm * 256 + ai * 128 + wr * 64 + m * 16 + fr; const float r = rr[ai][m];
                    f32x4 h0, h1;
#pragma unroll
                    for (int j = 0; j < 4; ++j) { h0[j] = siluf_(acc[ai][0][m][0][j] * r) * (acc[ai][1][m][0][j] * r); h1[j] = siluf_(acc[ai][0][m][1][j] * r) * (acc[ai][1][m][1][j] * r); }
                    *(u32x4*)(H + (size_t)row * FF + u.pn * 128 + wc * 32 + 8 * fq) = pack8(h0, h1);
                }
        } else {
            bf16_t* base = KV + (size_t)(u.pm * 256) * 2048 + u.pn * 256;
#pragma unroll
            for (int ai = 0; ai < 2; ++ai)
#pragma unroll
                for (int m = 0; m < 4; ++m) { const int rl = ai * 128 + wr * 64 + m * 16 + fr;
#pragma unroll
                    for (int bj = 0; bj < 2; ++bj) *(u32x4*)(base + (size_t)rl * 2048 + bj * 128 + wc * 32 + 8 * fq) = pack8(acc[ai][bj][m][0], acc[ai][bj][m][1]); }
        }
    }
};
struct EpiPre {
    static constexpr bool PERM = true;
    bf16_t* O; int mode;
    __device__ __forceinline__ void operator()(Acc& acc, const Unit& u, int wr, int wc, int fr, int fq) const {
        bf16_t* base = O + (size_t)(u.pm >> 2) * 1048576 + (mode ? (size_t)(u.pn * 256) * 1024 + (u.pm & 3) * 256 : (size_t)((u.pm & 3) * 256) * 1024 + u.pn * 256);
#pragma unroll
        for (int ai = 0; ai < 2; ++ai)
#pragma unroll
            for (int m = 0; m < 4; ++m) { const int rl = ai * 128 + wr * 64 + m * 16 + fr;
#pragma unroll
                for (int bj = 0; bj < 2; ++bj) *(u32x4*)(base + (size_t)rl * 1024 + bj * 128 + wc * 32 + 8 * fq) = pack8(acc[ai][bj][m][0], acc[ai][bj][m][1]); }
    }
};
struct EpiResid {
    static constexpr bool PERM = true;
    bf16_t* xb; float* ssq; float alpha;
    __device__ __forceinline__ void operator()(Acc& acc, const Unit& u, int wr, int wc, int fr, int fq) const {
#pragma unroll
        for (int ai = 0; ai < 2; ++ai)
#pragma unroll
            for (int m = 0; m < 4; ++m) {
                const int row = u.pm * 256 + ai * 128 + wr * 64 + m * 16 + fr; float ss = 0.f;
#pragma unroll
                for (int bj = 0; bj < 2; ++bj) { bf16_t* p = xb + (size_t)row * D + u.pn * 256 + bj * 128 + wc * 32 + 8 * fq; const u32x4 b = *(const u32x4*)p;
                    f32x4 o0, o1; o0[0] = bflo(b.x); o0[1] = bfhi(b.x); o0[2] = bflo(b.y); o0[3] = bfhi(b.y); o1[0] = bflo(b.z); o1[1] = bfhi(b.z); o1[2] = bflo(b.w); o1[3] = bfhi(b.w);
                    o0 = o0 + acc[ai][bj][m][0] * alpha; o1 = o1 + acc[ai][bj][m][1] * alpha;
                    ss += ((o0[0] * o0[0] + o0[1] * o0[1]) + (o0[2] * o0[2] + o0[3] * o0[3])) + ((o1[0] * o1[0] + o1[1] * o1[1]) + (o1[2] * o1[2] + o1[3] * o1[3]));
                    *(u32x4*)p = pack8(o0, o1); }
                ss += __shfl_xor(ss, 16); ss += __shfl_xor(ss, 32);
                if (fq == 0) ssq[(size_t)row * 16 + u.pn * 4 + wc] = ss;
            }
    }
};
template <bool USE_R> struct EpiScaleBf16 {
    static constexpr bool PERM = true;
    bf16_t* O; int ldc; const float* ssq;
    __device__ __forceinline__ void operator()(Acc& acc, const Unit& u, int wr, int wc, int fr, int fq) const {
        float rr[2][4]; if (USE_R) rows_rs(ssq, u.pm * 256 + wr * 64 + fr, fq, rr);
#pragma unroll
        for (int ai = 0; ai < 2; ++ai)
#pragma unroll
            for (int m = 0; m < 4; ++m) { const int row = u.pm * 256 + ai * 128 + wr * 64 + m * 16 + fr; const float r = USE_R ? rr[ai][m] : 1.f;
#pragma unroll
                for (int bj = 0; bj < 2; ++bj) *(u32x4*)(O + (size_t)row * ldc + u.pn * 256 + bj * 128 + wc * 32 + 8 * fq) = pack8(acc[ai][bj][m][0] * r, acc[ai][bj][m][1] * r); }
    }
};
struct EpiYB {
    static constexpr bool PERM = true;
    bf16_t* proj;
    __device__ __forceinline__ void operator()(Acc& acc, const Unit& u, int wr, int wc, int fr, int fq) const {
#pragma unroll
        for (int ai = 0; ai < 2; ++ai)
#pragma unroll
            for (int m = 0; m < 4; ++m) { const int row = u.pm * 256 + ai * 128 + wr * 64 + m * 16 + fr;
#pragma unroll
                for (int bj = 0; bj < 2; ++bj) { bf16_t* p = proj + (size_t)row * NPROJ + PGB0 + u.pn * 256 + bj * 128 + wc * 32 + 8 * fq; const u32x4 g = *(const u32x4*)p;
                    f32x4 v0, v1; v0[0] = sigmoidf_(bflo(g.x)); v0[1] = sigmoidf_(bfhi(g.x)); v0[2] = sigmoidf_(bflo(g.y)); v0[3] = sigmoidf_(bfhi(g.y));
                    v1[0] = sigmoidf_(bflo(g.z)); v1[1] = sigmoidf_(bfhi(g.z)); v1[2] = sigmoidf_(bflo(g.w)); v1[3] = sigmoidf_(bfhi(g.w));
                    *(u32x4*)p = pack8(v0 * acc[ai][bj][m][0], v1 * acc[ai][bj][m][1]); } }
    }
};
struct EpiMG {
    static constexpr bool PERM = true;
    bf16_t* proj;
    __device__ __forceinline__ void operator()(Acc& acc, const Unit& u, int wr, int wc, int fr, int fq) const {
#pragma unroll
        for (int ai = 0; ai < 2; ++ai)
#pragma unroll
            for (int m = 0; m < 4; ++m) { const int row = u.pm * 256 + ai * 128 + wr * 64 + m * 16 + fr;
#pragma unroll
                for (int bj = 0; bj < 2; ++bj) { const int col = u.pn * 256 + bj * 128 + wc * 32 + 8 * fq; bf16_t* p = proj + (size_t)row * NPROJ + PGA0 + col;
                    const u32x4 g = *(const u32x4*)p; const u32x4 y = *(const u32x4*)(proj + (size_t)row * NPROJ + PGB0 + col);
                    f32x4 v0, v1, y0, y1; v0[0] = sigmoidf_(bflo(g.x)); v0[1] = sigmoidf_(bfhi(g.x)); v0[2] = sigmoidf_(bflo(g.y)); v0[3] = sigmoidf_(bfhi(g.y));
                    v1[0] = sigmoidf_(bflo(g.z)); v1[1] = sigmoidf_(bfhi(g.z)); v1[2] = sigmoidf_(bflo(g.w)); v1[3] = sigmoidf_(bfhi(g.w));
                    y0[0] = bflo(y.x); y0[1] = bfhi(y.x); y0[2] = bflo(y.y); y0[3] = bfhi(y.y); y1[0] = bflo(y.z); y1[1] = bfhi(y.z); y1[2] = bflo(y.w); y1[3] = bfhi(y.w);
                    *(u32x4*)p = pack8(v0 * acc[ai][bj][m][0] + y0, v1 * acc[ai][bj][m][1] + y1); } }
    }
};
struct EpiSoftmax {
    static constexpr bool PERM = true;
    bf16_t* O; LAS float* scr; const float* ssq;
    __device__ __forceinline__ void operator()(Acc& acc, const Unit& u, int wr, int wc, int fr, int fq) const {
        LAS float* MX = scr; LAS float* SM = scr + 1024;
        float rr[2][4]; rows_rs(ssq, u.pm * 256 + wr * 64 + fr, fq, rr);
#pragma unroll
        for (int ai = 0; ai < 2; ++ai)
#pragma unroll
            for (int m = 0; m < 4; ++m) { float v = -3.0e38f; const float r = rr[ai][m];
#pragma unroll
                for (int bj = 0; bj < 2; ++bj)
#pragma unroll
                    for (int n = 0; n < 2; ++n)
#pragma unroll
                        for (int j = 0; j < 4; ++j) { acc[ai][bj][m][n][j] *= r; v = fmaxf(v, acc[ai][bj][m][n][j]); }
                v = fmaxf(v, __shfl_xor(v, 16)); v = fmaxf(v, __shfl_xor(v, 32));
                if (fq == 0) MX[(ai * 128 + wr * 64 + m * 16 + fr) * 4 + wc] = v; }
        LDS_WAIT(); __builtin_amdgcn_s_barrier(); asm volatile("" ::: "memory");
#pragma unroll
        for (int ai = 0; ai < 2; ++ai)
#pragma unroll
            for (int m = 0; m < 4; ++m) { const int rl = ai * 128 + wr * 64 + m * 16 + fr; const f32x4 q = *(const LAS f32x4*)(MX + rl * 4);
                const float mxr = fmaxf(fmaxf(q[0], q[1]), fmaxf(q[2], q[3])); float s = 0.f;
#pragma unroll
                for (int bj = 0; bj < 2; ++bj)
#pragma unroll
                    for (int n = 0; n < 2; ++n)
#pragma unroll
                        for (int j = 0; j < 4; ++j) { const float e = __expf(acc[ai][bj][m][n][j] - mxr); acc[ai][bj][m][n][j] = e; s += e; }
                s += __shfl_xor(s, 16); s += __shfl_xor(s, 32);
                if (fq == 0) SM[rl * 4 + wc] = s; }
        LDS_WAIT(); __builtin_amdgcn_s_barrier(); asm volatile("" ::: "memory");
#pragma unroll
        for (int ai = 0; ai < 2; ++ai)
#pragma unroll
            for (int m = 0; m < 4; ++m) { const int rl = ai * 128 + wr * 64 + m * 16 + fr; const f32x4 q = *(const LAS f32x4*)(SM + rl * 4);
                const float inv = __builtin_amdgcn_rcpf((q[0] + q[1]) + (q[2] + q[3])); const int row = u.pm * 256 + rl;
#pragma unroll
                for (int bj = 0; bj < 2; ++bj) *(u32x4*)(O + (size_t)row * 1024 + u.pn * 256 + bj * 128 + wc * 32 + 8 * fq) = pack8(acc[ai][bj][m][0] * inv, acc[ai][bj][m][1] * inv); }
    }
};

struct Args {
    const float* in[27]; float* out; unsigned char* ws; int ph_lo, ph_hi;
};
enum { I_X = 0, I_MEM, I_F1N, I_F1W1, I_F1W3, I_F1W2, I_MIXN, I_WIN, I_WAL, I_BAL, I_GHN, I_WUPA, I_PMIX, I_PSC, I_WUPB, I_WMIX, I_XAN, I_MEMN, I_XWQ, I_XWK, I_XWV, I_XWO,
       I_F2N, I_F2W1, I_F2W3, I_F2W2, I_FN };

__device__ __forceinline__ void cvt_item(const float* W, int ldw, int col0, int k0, const float* gain, float scale, bf16_t* dst, int ldd, int drow0, LAS float* scr, int lane) {
    float v[32], g[32];
    const float* wp = W + (size_t)(k0 + (lane >> 5)) * ldw + col0 + (lane & 31);
#pragma unroll
    for (int i = 0; i < 32; ++i) v[i] = wp[(size_t)(2 * i) * ldw];
    if (gain) {
#pragma unroll
        for (int i = 0; i < 32; ++i) g[i] = gain[k0 + 2 * i + (lane >> 5)];
    }
#pragma unroll
    for (int i = 0; i < 32; ++i) scr[(2 * i + (lane >> 5)) * 33 + (lane & 31)] = v[i] * (gain ? g[i] * scale : scale);
    LDS_WAIT(); asm volatile("" ::: "memory");
    const int c = lane & 7;
#pragma unroll
    for (int j = 0; j < 4; ++j) { const int n = (lane >> 3) + 8 * j; const LAS float* s = scr + (8 * c) * 33 + n;
        u32x4 o; o.x = pk2(s[0 * 33], s[1 * 33]); o.y = pk2(s[2 * 33], s[3 * 33]); o.z = pk2(s[4 * 33], s[5 * 33]); o.w = pk2(s[6 * 33], s[7 * 33]);
        *(u32x4*)(dst + (size_t)(drow0 + n) * ldd + k0 + 8 * c) = o; }
    LDS_WAIT(); asm volatile("" ::: "memory");
}
__device__ __forceinline__ void cvt_plain(const float* W, int K, int N, const float* gain, float scale, bf16_t* dst, int drow_off, LAS float* scr, int it, int lane) {
    const int nblk = N / 32, kb = it / nblk, nb = it % nblk;
    cvt_item(W, N, nb * 32, kb * 64, gain, scale, dst, K, drow_off + nb * 32, scr, lane);
}
__device__ __forceinline__ void cvt_w13(const float* W1, const float* W3, const float* gain, bf16_t* dst, LAS float* scr, int it, int lane) {
    const int nblk = 5632 / 32, kb = it / nblk, nb = it % nblk, pn = nb >> 3, cb = nb & 7;
    cvt_item(cb < 4 ? W1 : W3, FF, pn * 128 + (cb & 3) * 32, kb * 64, gain, 1.f, dst, 1024, nb * 32, scr, lane);
}
__device__ __forceinline__ void cvt_win(const float* W, const float* gain, bf16_t* dst, LAS float* scr, int it, int lane) {
    const int nblk = NPROJ / 32, kb = it / nblk, nb = it % nblk, n0 = nb * 32;
    cvt_item(W, WIN_LD, n0 + (n0 >= 3072 ? 16 : 0), kb * 64, gain, 1.f, dst, 1024, n0, scr, lane);
}
constexpr int PI13 = 176 * 16, PI2 = 32 * 44, PISQ = 32 * 16;
constexpr int PREP_EARLY = PI13 + 2 * PISQ, PREP_NITEMS = 2 * PI13 + PI2 + 6 * PISQ + 1024 + 16;
__device__ __forceinline__ void prep_items(const Args& a, LAS unsigned char* lds, int first, int last, int gw, int NGW) {
    const int tid = threadIdx.x, lane = tid & 63, wave = __builtin_amdgcn_readfirstlane(tid >> 6);
    LAS float* scr = (LAS float*)(lds + wave * 16384);
    unsigned char* ws = a.ws;
    constexpr int I13 = PI13, I2 = PI2, ISQ = PISQ;
    for (int it = first + gw; it < last; it += NGW) {
        int r = it;
        if (r < I13) { cvt_w13(a.in[I_F1W1], a.in[I_F1W3], a.in[I_F1N], (bf16_t*)(ws + W_1C1), scr, r, lane); continue; } r -= I13;
        if (r < ISQ) { cvt_plain(a.in[I_XWK], D, D, a.in[I_MEMN], 1.f, (bf16_t*)(ws + W_KV), 0, scr, r, lane); continue; } r -= ISQ;
        if (r < ISQ) { cvt_plain(a.in[I_XWV], D, D, a.in[I_MEMN], 1.f, (bf16_t*)(ws + W_KV), 1024, scr, r, lane); continue; } r -= ISQ;
        if (r < I2) { cvt_plain(a.in[I_F1W2], FF, D, nullptr, 1.f, (bf16_t*)(ws + W_21), 0, scr, r, lane); continue; } r -= I2;
        if (r < I13) { cvt_win(a.in[I_WIN], a.in[I_MIXN], (bf16_t*)(ws + W_IN), scr, r, lane); continue; } r -= I13;
        if (r < 16) {
            const int k = r * 64 + lane; const float g = a.in[I_MIXN][k]; const float* w = a.in[I_WIN] + (size_t)k * WIN_LD + 3072;
#pragma unroll
            for (int j = 0; j < 16; ++j) ((bf16_t*)(ws + W_AT))[j * 1024 + k] = (bf16_t)f2bf(w[j] * g);
            continue; } r -= 16;
        if (r < ISQ) { cvt_plain(a.in[I_WUPA], D, D, nullptr, 1.f, (bf16_t*)(ws + W_UPA), 0, scr, r, lane); continue; } r -= ISQ;
        if (r < ISQ) { cvt_plain(a.in[I_WMIX], D, D, nullptr, 1.f, (bf16_t*)(ws + W_MIX), 0, scr, r, lane); continue; } r -= ISQ;
        if (r < ISQ) {
            const int k = r * 2 + (lane >> 5); const float g = a.in[I_XAN][k] * 0.0625f; const float* w = a.in[I_XWQ] + (size_t)k * D + (lane & 31) * 32; bf16_t* o = (bf16_t*)(ws + W_Q) + (size_t)k * D + (lane & 31) * 32;
#pragma unroll
            for (int q = 0; q < 4; ++q) { const f32x4 v0 = *(const f32x4*)(w + q * 8), v1 = *(const f32x4*)(w + q * 8 + 4); *(u32x4*)(o + q * 8) = pack8(v0 * g, v1 * g); }
            continue; } r -= ISQ;
        if (r < ISQ) { cvt_plain(a.in[I_XWO], D, D, nullptr, 1.f, (bf16_t*)(ws + W_O), 0, scr, r, lane); continue; } r -= ISQ;
        {
            const int gi = r >> 8, co = (r >> 4) & 15, nb = r & 15, n = nb * 64 + lane;
            const float* pm = a.in[I_PMIX] + (size_t)(gi * 128 + co * 8) * 128;
#pragma unroll
            for (int i = 0; i < 16; ++i) scr[i * 64 + lane] = pm[i * 64 + lane];
            LDS_WAIT(); asm volatile("" ::: "memory");
            float acc[8] = {0.f, 0.f, 0.f, 0.f, 0.f, 0.f, 0.f, 0.f};
            const float* wb = a.in[I_WUPB] + (size_t)(gi * 128) * 1024 + n; const float* sc = a.in[I_PSC] + gi * 128;
#pragma unroll 8
            for (int d = 0; d < 128; ++d) { const float wv = wb[(size_t)d * 1024] * sc[d];
#pragma unroll
                for (int cc = 0; cc < 8; ++cc) acc[cc] += scr[cc * 128 + d] * wv; }
            u32x4 o; o.x = pk2(acc[0], acc[1]); o.y = pk2(acc[2], acc[3]); o.z = pk2(acc[4], acc[5]); o.w = pk2(acc[6], acc[7]);
            *(u32x4*)((bf16_t*)(ws + W_PB) + (size_t)n * 512 + gi * 128 + co * 8) = o;
            LDS_WAIT(); asm volatile("" ::: "memory");
        }
    }
}
__device__ __forceinline__ void prep_late(const Args& a, LAS unsigned char* lds) {
    const int tid = threadIdx.x, lane = tid & 63, wave = __builtin_amdgcn_readfirstlane(tid >> 6);
    LAS float* scr = (LAS float*)(lds + wave * 16384);
    for (int it = blockIdx.x * 8 + wave; it < PI13 + PI2; it += gridDim.x * 8) {
        if (it < PI13) cvt_w13(a.in[I_F2W1], a.in[I_F2W3], a.in[I_F2N], (bf16_t*)(a.ws + W_1C2), scr, it, lane);
        else cvt_plain(a.in[I_F2W2], FF, D, nullptr, 1.f, (bf16_t*)(a.ws + W_22), 0, scr, it - PI13, lane);
    }
}
__device__ __forceinline__ void phase_prep_rows(const Args& a) {
    const int tid = threadIdx.x, lane = tid & 63, wave = __builtin_amdgcn_readfirstlane(tid >> 6);
    const int gw = blockIdx.x * 8 + wave, NGW = gridDim.x * 8;
    unsigned char* ws = a.ws;
    for (int m0 = gw; m0 < T + NBATCH * MEMLEN; m0 += 2 * NGW) {
        f32x4 v[2][4]; float s[2];
#pragma unroll
        for (int q = 0; q < 2; ++q) { const int m = m0 + q * NGW; const bool ok = m < T + NBATCH * MEMLEN; const bool isx = m < T; const int r = isx ? m : m - T;
            const f32x4* xr = (const f32x4*)((isx ? a.in[I_X] : a.in[I_MEM]) + (size_t)(ok ? r : 0) * D) + lane;
#pragma unroll
            for (int j = 0; j < 4; ++j) v[q][j] = xr[64 * j]; }
#pragma unroll
        for (int q = 0; q < 2; ++q) { const int m = m0 + q * NGW; if (m >= T + NBATCH * MEMLEN) continue; const bool isx = m < T; const int r = isx ? m : m - T;
            float ss = 0.f;
#pragma unroll
            for (int j = 0; j < 4; ++j) ss += (v[q][j][0] * v[q][j][0] + v[q][j][1] * v[q][j][1]) + (v[q][j][2] * v[q][j][2] + v[q][j][3] * v[q][j][3]);
            ss = wave_sum(ss); s[q] = ss;
            float sc = 1.f;
            if (isx) { if (lane < 16) ((float*)(ws + WS_SSQ))[(size_t)r * 16 + lane] = lane == 0 ? ss : 0.f; }
            else sc = __builtin_amdgcn_rsqf(ss * (1.0f / D) + EPS);
            u32x2* o8 = (u32x2*)((bf16_t*)(ws + (isx ? WS_XB : WS_MB)) + (size_t)r * D) + lane;
#pragma unroll
            for (int j = 0; j < 4; ++j) { u32x2 w; w.x = pk2(v[q][j][0] * sc, v[q][j][1] * sc); w.y = pk2(v[q][j][2] * sc, v[q][j][3] * sc); o8[64 * j] = w; } }
        (void)s;
    }
}

__device__ __forceinline__ void phase_acode(const Args& a) {
    const int tid = threadIdx.x, lane = tid & 63, wave = tid >> 6, fr = lane & 15, fq = lane >> 4;
    const bf16_t* XB = (const bf16_t*)(a.ws + WS_XB); const bf16_t* WAT = (const bf16_t*)(a.ws + W_AT); const float* ssq = (const float*)(a.ws + WS_SSQ); float* AC = (float*)(a.ws + WS_ACODE);
    for (int rg = blockIdx.x * 8 + wave; rg < T / 16; rg += gridDim.x * 8) {
        const bf16_t* ap = XB + (size_t)(rg * 16 + fr) * D + fq * 8; const bf16_t* bp = WAT + (size_t)fr * D + fq * 8;
        f32x4 c = {0.f, 0.f, 0.f, 0.f};
#pragma unroll 8
        for (int kk = 0; kk < 32; ++kk) { const bf16x8 xa = *(const bf16x8*)(ap + kk * 32); const bf16x8 wb = *(const bf16x8*)(bp + kk * 32);
            c = __builtin_amdgcn_mfma_f32_16x16x32_bf16(wb, xa, c, 0, 0, 0); }
        const float r = row_rs4(ssq, rg * 16 + fr, fq);
        *(f32x4*)(AC + (size_t)(rg * 16 + fr) * 16 + 4 * fq) = c * r;
    }
}

__device__ __forceinline__ void ld8(const bf16_t* p, float* f) { const u32x4 w = *(const u32x4*)p; f[0] = bflo(w.x); f[1] = bfhi(w.x); f[2] = bflo(w.y); f[3] = bfhi(w.y); f[4] = bflo(w.z); f[5] = bfhi(w.z); f[6] = bflo(w.w); f[7] = bfhi(w.w); }
__device__ __forceinline__ void phase_pool(const Args& a) {
    const int tid = threadIdx.x, co = tid & 63, tsub = tid >> 6, gi = co >> 4, w = 2 << gi;
    const bf16_t* __restrict__ U = (const bf16_t*)(a.ws + WS_PROJ) + PU0 + co * 8; bf16_t* __restrict__ P = (bf16_t*)a.out + co * 8;
    for (int tile = blockIdx.x; tile < T / 64; tile += gridDim.x) {
        const int t0 = tile * 64 + tsub * 8, p0 = t0 & (SEQ - 1);
        float acc[8] = {0.f, 0.f, 0.f, 0.f, 0.f, 0.f, 0.f, 0.f}, f[8];
        for (int d = 1; d < w; ++d) if (p0 - d >= 0) { ld8(U + (size_t)(t0 - d) * NPROJ, f);
#pragma unroll
            for (int c = 0; c < 8; ++c) acc[c] += f[c]; }
        for (int k = 0; k < 8; ++k) {
            const int t = t0 + k, p = p0 + k; ld8(U + (size_t)t * NPROJ, f);
            const float inv = 1.0f / (float)(p + 1 < w ? p + 1 : w);
            float o[8];
#pragma unroll
            for (int c = 0; c < 8; ++c) { acc[c] += f[c]; o[c] = acc[c] * inv - f[c]; }
            u32x4 ow; ow.x = pk2(o[0], o[1]); ow.y = pk2(o[2], o[3]); ow.z = pk2(o[4], o[5]); ow.w = pk2(o[6], o[7]);
            *(u32x4*)(P + (size_t)t * 512) = ow;
            if (p - w + 1 >= 0) { float g[8]; ld8(U + (size_t)(t - w + 1) * NPROJ, g);
#pragma unroll
                for (int c = 0; c < 8; ++c) acc[c] -= g[c]; }
        }
    }
}

constexpr int GL_QT = 0, GL_KT = 17408, GL_KD = 34816, GL_VT = 53248, GL_PM = 90112, GL_TOT = 99328, GL_DL = 101376, GL_RS = 101888, GL_AC = 103936;
template <int MODE> __device__ __forceinline__ void gla_units(const Args& a, LAS unsigned char* lds) {
    const int tid = threadIdx.x, lane = tid & 63, wave = __builtin_amdgcn_readfirstlane(tid >> 6), fr = lane & 15, fq = lane >> 4;
    LAS bf16_t* QT = (LAS bf16_t*)(lds + GL_QT); LAS bf16_t* KT = (LAS bf16_t*)(lds + GL_KT); LAS bf16_t* KD = (LAS bf16_t*)(lds + GL_KD);
    LAS bf16_t* VT = (LAS bf16_t*)(lds + GL_VT); LAS bf16_t* PM = (LAS bf16_t*)(lds + GL_PM);
    LAS float* TOT = (LAS float*)(lds + GL_TOT); LAS float* DL = (LAS float*)(lds + GL_DL); LAS float* RS = (LAS float*)(lds + GL_RS); LAS float* ACL = (LAS float*)(lds + GL_AC);
    bf16_t* PROJ = (bf16_t*)(a.ws + WS_PROJ); const float* AC = (const float*)(a.ws + WS_ACODE);
    bf16_t* STG = (bf16_t*)((char*)a.out + 32 * MiB); float* LDG = (float*)(a.ws + WS_LDG);
    const int dk = tid & 127, pg = wave >> 1;
    const int dv = tid & 255, ph = wave >> 2;
    for (int unit = blockIdx.x; unit < 512; unit += gridDim.x) {
        const int bh = unit >> 4, g = unit & 15, b = bh >> 2, h = bh & 3;
        const size_t row0 = (size_t)b * SEQ + g * 256;
        float wal[16];
#pragma unroll
        for (int j = 0; j < 16; ++j) wal[j] = a.in[I_WAL][j * 512 + h * 128 + dk];
        const float bal = a.in[I_BAL][h * 128 + dk];
        f32x4 st[8][2];
        if (MODE == 1) {
            const u32x2* sp = (const u32x2*)(STG + (size_t)unit * 32768) + (wave * 16) * 64 + lane;
#pragma unroll
            for (int tk = 0; tk < 8; ++tk)
#pragma unroll
                for (int tv = 0; tv < 2; ++tv) { const u32x2 w = sp[(tk * 2 + tv) * 64]; st[tk][tv] = (f32x4){bflo(w.x), bfhi(w.x), bflo(w.y), bfhi(w.y)}; }
        } else {
#pragma unroll
            for (int tk = 0; tk < 8; ++tk)
#pragma unroll
                for (int tv = 0; tv < 2; ++tv) st[tk][tv] = (f32x4){0.f, 0.f, 0.f, 0.f};
        }
        float lsum = 0.f;
        {
            const f32x4* src = (const f32x4*)(AC + row0 * 16); LAS f32x4* dst = (LAS f32x4*)ACL;
            dst[tid] = src[tid]; dst[tid + 512] = src[tid + 512];
        }
        for (int c = 0; c < 4; ++c) {
            const size_t rowc = row0 + c * 64;
            unsigned short vraw[32];
            { const bf16_t* vp = PROJ + (rowc + ph * 32) * NPROJ + PV0 + h * 256 + dv;
#pragma unroll
              for (int i = 0; i < 32; ++i) vraw[i] = vp[(size_t)i * NPROJ]; }
            float bl[16]; float run = 0.f;
            if (c == 0) { LDS_WAIT(); __builtin_amdgcn_s_barrier(); asm volatile("" ::: "memory"); }
            { const LAS f32x4* acp = (const LAS f32x4*)(ACL + (c * 64 + pg * 16) * 16);
#pragma unroll
              for (int i = 0; i < 16; ++i) { const f32x4 c0 = acp[i * 4 + 0], c1 = acp[i * 4 + 1], c2 = acp[i * 4 + 2], c3 = acp[i * 4 + 3];
                  float z = bal;
                  z += c0[0] * wal[0] + c0[1] * wal[1] + c0[2] * wal[2] + c0[3] * wal[3]; z += c1[0] * wal[4] + c1[1] * wal[5] + c1[2] * wal[6] + c1[3] * wal[7];
                  z += c2[0] * wal[8] + c2[1] * wal[9] + c2[2] * wal[10] + c2[3] * wal[11]; z += c3[0] * wal[12] + c3[1] * wal[13] + c3[2] * wal[14] + c3[3] * wal[15];
                  const float ls = fminf(z, 0.f) - __logf(1.f + __expf(-fabsf(z)));
                  run += ls * 0.0625f; bl[i] = run; } }
            unsigned short qraw[16], kraw[16];
            { const bf16_t* qp = PROJ + (rowc + pg * 16) * NPROJ + PQ0 + h * 128 + dk;
#pragma unroll
              for (int i = 0; i < 16; ++i) { qraw[i] = qp[(size_t)i * NPROJ]; kraw[i] = qp[(size_t)i * NPROJ + (PK0 - PQ0)]; } }
            TOT[pg * 128 + dk] = run;
            LDS_WAIT(); __builtin_amdgcn_s_barrier(); asm volatile("" ::: "memory");
            const float t0 = TOT[dk], t1 = TOT[128 + dk], t2 = TOT[256 + dk], t3 = TOT[384 + dk];
            const float offs = pg == 0 ? 0.f : pg == 1 ? t0 : pg == 2 ? t0 + t1 : (t0 + t1) + t2;
            const float blast = ((t0 + t1) + t2) + t3;
            lsum += blast;
            { unsigned kd[8];
#pragma unroll
              for (int i = 0; i < 16; ++i) { const float bc = offs + bl[i]; const float eq = __expf(bc), ek = __builtin_amdgcn_rcpf(eq);
                  const int pos = pg * 16 + i;
                  if (MODE == 1) QT[pos * 136 + dk] = (bf16_t)f2bf(bf2f(qraw[i]) * 0.08838834764831845f * eq);
                  const unsigned kt = f2bf(bf2f(kraw[i]) * ek);
                  if (MODE == 1) KT[pos * 136 + dk] = (bf16_t)kt;
                  if (i & 1) kd[i >> 1] |= kt << 16; else kd[i >> 1] = kt; }
              *(LAS u32x4*)(KD + dk * 72 + pg * 16) = (u32x4){kd[0], kd[1], kd[2], kd[3]};
              *(LAS u32x4*)(KD + dk * 72 + pg * 16 + 8) = (u32x4){kd[4], kd[5], kd[6], kd[7]}; }
            if (pg == 0) DL[dk] = __expf(blast);
            {
#pragma unroll
              for (int q = 0; q < 4; ++q) { u32x4 w; w.x = vraw[q * 8 + 0] | ((unsigned)vraw[q * 8 + 1] << 16); w.y = vraw[q * 8 + 2] | ((unsigned)vraw[q * 8 + 3] << 16);
                  w.z = vraw[q * 8 + 4] | ((unsigned)vraw[q * 8 + 5] << 16); w.w = vraw[q * 8 + 6] | ((unsigned)vraw[q * 8 + 7] << 16);
                  *(LAS u32x4*)(VT + dv * 72 + ph * 32 + q * 8) = w; } }
            LDS_WAIT(); __builtin_amdgcn_s_barrier(); asm volatile("" ::: "memory");
            if (MODE == 1) {
                { const int ti = wave >> 1;
#pragma unroll
                  for (int jj = 0; jj < 2; ++jj) { const int tj = (wave & 1) * 2 + jj; f32x4 s = {0.f, 0.f, 0.f, 0.f};
                      if (tj <= ti) {
#pragma unroll
                          for (int kk = 0; kk < 4; ++kk) { const bf16x8 kf = *(const LAS bf16x8*)(KT + (tj * 16 + fr) * 136 + kk * 32 + fq * 8); const bf16x8 qf = *(const LAS bf16x8*)(QT + (ti * 16 + fr) * 136 + kk * 32 + fq * 8);
                              s = __builtin_amdgcn_mfma_f32_16x16x32_bf16(kf, qf, s, 0, 0, 0); } }
                      const int i = ti * 16 + fr, j0 = tj * 16 + fq * 4;
                      u32x2 w; w.x = pk2m(j0 + 0 <= i ? s[0] : 0.f, j0 + 1 <= i ? s[1] : 0.f); w.y = pk2m(j0 + 2 <= i ? s[2] : 0.f, j0 + 3 <= i ? s[3] : 0.f);
                      *(LAS u32x2*)(PM + i * 72 + j0) = w; } }
                LDS_WAIT(); __builtin_amdgcn_s_barrier(); asm volatile("" ::: "memory");
                f32x4 oa[2][4];
#pragma unroll
                for (int tv = 0; tv < 2; ++tv)
#pragma unroll
                    for (int ti = 0; ti < 4; ++ti) { f32x4 o = {0.f, 0.f, 0.f, 0.f};
#pragma unroll
                        for (int kk = 0; kk < 2; ++kk) { if (kk * 32 > ti * 16 + 15) continue;
                            const bf16x8 vf = *(const LAS bf16x8*)(VT + (wave * 32 + tv * 16 + fr) * 72 + kk * 32 + fq * 8); const bf16x8 pf = *(const LAS bf16x8*)(PM + (ti * 16 + fr) * 72 + kk * 32 + fq * 8);
                            o = __builtin_amdgcn_mfma_f32_16x16x32_bf16(vf, pf, o, 0, 0, 0); }
#pragma unroll
                        for (int tp = 0; tp < 4; ++tp) {
                            const f32x4 s0 = st[2 * tp][tv], s1 = st[2 * tp + 1][tv]; u32x4 sw; sw.x = pk2m(s0[0], s0[1]); sw.y = pk2m(s0[2], s0[3]); sw.z = pk2m(s1[0], s1[1]); sw.w = pk2m(s1[2], s1[3]);
                            const u32x2 q0 = *(const LAS u32x2*)(QT + (ti * 16 + fr) * 136 + tp * 32 + fq * 4), q1 = *(const LAS u32x2*)(QT + (ti * 16 + fr) * 136 + tp * 32 + 16 + fq * 4);
                            const u32x4 qw = {q0.x, q0.y, q1.x, q1.y};
                            o = __builtin_amdgcn_mfma_f32_16x16x32_bf16(__builtin_bit_cast(bf16x8, sw), __builtin_bit_cast(bf16x8, qw), o, 0, 0, 0); }
                        oa[tv][ti] = o; }
                u32x2 rwv[4][2]; f32x4 gnv[2];
#pragma unroll
                for (int tv = 0; tv < 2; ++tv) gnv[tv] = *(const f32x4*)(a.in[I_GHN] + wave * 32 + tv * 16 + fq * 4);
#pragma unroll
                for (int ti = 0; ti < 4; ++ti)
#pragma unroll
                    for (int tv = 0; tv < 2; ++tv) rwv[ti][tv] = *(const u32x2*)(PROJ + (rowc + ti * 16 + fr) * NPROJ + PR0 + h * 256 + wave * 32 + tv * 16 + fq * 4);
#pragma unroll
                for (int ti = 0; ti < 4; ++ti) { float ss = 0.f;
#pragma unroll
                    for (int tv = 0; tv < 2; ++tv) { const f32x4 o = oa[tv][ti]; ss += (o[0] * o[0] + o[1] * o[1]) + (o[2] * o[2] + o[3] * o[3]); }
                    ss += __shfl_xor(ss, 16); ss += __shfl_xor(ss, 32);
                    if (fq == 0) RS[wave * 64 + ti * 16 + fr] = ss; }
                LDS_WAIT(); __builtin_amdgcn_s_barrier(); asm volatile("" ::: "memory");
#pragma unroll
                for (int ti = 0; ti < 4; ++ti) { const int i = ti * 16 + fr; float ss = 0.f;
#pragma unroll
                    for (int w8 = 0; w8 < 8; ++w8) ss += RS[w8 * 64 + i];
                    const float rn = __builtin_amdgcn_rsqf(ss * (1.0f / 256.0f) + EPS);
#pragma unroll
                    for (int tv = 0; tv < 2; ++tv) { const int v0 = wave * 32 + tv * 16 + fq * 4;
                        const f32x4 gn = gnv[tv];
                        bf16_t* pr = PROJ + (rowc + i) * NPROJ + h * 256 + v0; const u32x2 rw = rwv[ti][tv];
                        const f32x4 o = oa[tv][ti]; u32x2 w;
                        w.x = pk2m(o[0] * rn * gn[0] * siluf_(bflo(rw.x)), o[1] * rn * gn[1] * siluf_(bfhi(rw.x)));
                        w.y = pk2m(o[2] * rn * gn[2] * siluf_(bflo(rw.y)), o[3] * rn * gn[3] * siluf_(bfhi(rw.y)));
                        *(u32x2*)(pr + PV0) = w; } }
            }
            if (MODE == 0 || c < 3) {
#pragma unroll
                for (int tk = 0; tk < 8; ++tk) { const f32x4 dd = *(const LAS f32x4*)(DL + tk * 16 + fq * 4);
#pragma unroll
                    for (int tv = 0; tv < 2; ++tv) { f32x4 s = st[tk][tv];
#pragma unroll
                        for (int kk = 0; kk < 2; ++kk) { const bf16x8 kf = *(const LAS bf16x8*)(KD + (tk * 16 + fr) * 72 + kk * 32 + fq * 8); const bf16x8 vf = *(const LAS bf16x8*)(VT + (wave * 32 + tv * 16 + fr) * 72 + kk * 32 + fq * 8);
                            s = __builtin_amdgcn_mfma_f32_16x16x32_bf16(kf, vf, s, 0, 0, 0); }
                        st[tk][tv] = s * dd; } }
            }
        }
        if (MODE == 0) {
            u32x2* sp = (u32x2*)(STG + (size_t)unit * 32768) + (wave * 16) * 64 + lane;
#pragma unroll
            for (int tk = 0; tk < 8; ++tk)
#pragma unroll
                for (int tv = 0; tv < 2; ++tv) { const f32x4 s = st[tk][tv]; u32x2 w; w.x = pk2m(s[0], s[1]); w.y = pk2m(s[2], s[3]); sp[(tk * 2 + tv) * 64] = w; }
            if (pg == 0) LDG[unit * 128 + dk] = lsum;
        }
    }
    LDS_WAIT(); __syncthreads();
}
__device__ __forceinline__ void phase_gla_scan(const Args& a) {
    bf16_t* STG = (bf16_t*)((char*)a.out + 32 * MiB); const float* LDG = (const float*)(a.ws + WS_LDG);
    for (int e = blockIdx.x * 512 + threadIdx.x; e < 32 * 8192; e += gridDim.x * 512) {
        const int bh = e >> 13, slot = e & 8191, lane = slot & 63, tl = (slot >> 6) & 15, k0 = (tl >> 1) * 16 + (lane >> 4) * 4;
        u32x2* p = (u32x2*)(STG + (size_t)bh * 16 * 32768) + slot;
        u32x2 uu[16];
#pragma unroll
        for (int g = 0; g < 16; ++g) uu[g] = p[(size_t)g * 8192];
        f32x4 s = {0.f, 0.f, 0.f, 0.f};
#pragma unroll
        for (int g = 0; g < 16; ++g) {
            u32x2 w; w.x = pk2(s[0], s[1]); w.y = pk2(s[2], s[3]); p[(size_t)g * 8192] = w;
            const f32x4 ld = *(const f32x4*)(LDG + (bh * 16 + g) * 128 + k0);
            s[0] = __expf(ld[0]) * s[0] + bflo(uu[g].x); s[1] = __expf(ld[1]) * s[1] + bfhi(uu[g].x);
            s[2] = __expf(ld[2]) * s[2] + bflo(uu[g].y); s[3] = __expf(ld[3]) * s[3] + bfhi(uu[g].y);
        }
    }
}
__device__ __forceinline__ void phase_final(const Args& a) {
    const int lane = threadIdx.x & 63, wave = threadIdx.x >> 6; const float* __restrict__ ssq = (const float*)(a.ws + WS_SSQ); const bf16_t* __restrict__ XB = (const bf16_t*)(a.ws + WS_XB);
    float* __restrict__ out = a.out; const f32x4* gp = (const f32x4*)a.in[I_FN] + 2 * lane;
    const f32x4 g00 = gp[0], g01 = gp[1], g10 = gp[128], g11 = gp[129];
    const int NW = gridDim.x * 8;
    for (int m0 = blockIdx.x * 8 + wave; m0 < T; m0 += 4 * NW) {
        u32x4 b[4][2]; float r[4];
#pragma unroll
        for (int q = 0; q < 4; ++q) { const int m = m0 + q * NW < T ? m0 + q * NW : m0; const u32x4* xr = (const u32x4*)(XB + (size_t)m * D) + lane; b[q][0] = xr[0]; b[q][1] = xr[64]; r[q] = row_rs(ssq, m); }
#pragma unroll
        for (int q = 0; q < 4; ++q) { const int m = m0 + q * NW; if (m >= T) continue; f32x4* orow = (f32x4*)(out + (size_t)m * D) + 2 * lane;
#pragma unroll
            for (int j = 0; j < 2; ++j) { const u32x4 w = b[q][j]; f32x4 o0, o1; o0[0] = bflo(w.x); o0[1] = bfhi(w.x); o0[2] = bflo(w.y); o0[3] = bfhi(w.y); o1[0] = bflo(w.z); o1[1] = bfhi(w.z); o1[2] = bflo(w.w); o1[3] = bfhi(w.w);
                orow[128 * j] = o0 * r[q] * (j ? g10 : g00); orow[128 * j + 1] = o1 * r[q] * (j ? g11 : g01); } }
    }
}

#define XB_TMO      128
#define XB_XCNT(j)  (256  + 64 * (j))
#define XB_XSUB(j)  (1280 + 64 * (j))
#define XB_XGEN(j)  (2304 + 64 * (j))
#define XB_TOP      3328
#define XB_TOPGEN   3392
#define XCD_BAR_WORDS 3456
#define XB_SPIN_CAP (1u << 22)
__device__ __forceinline__ unsigned xb_ld(unsigned* p)              { return __hip_atomic_load(p, __ATOMIC_RELAXED, __HIP_MEMORY_SCOPE_AGENT); }
__device__ __forceinline__ unsigned xb_add(unsigned* p, unsigned v) { return __hip_atomic_fetch_add(p, v, __ATOMIC_RELAXED, __HIP_MEMORY_SCOPE_AGENT); }
__device__ __forceinline__ unsigned xb_xcc_id() { return (unsigned)__builtin_amdgcn_s_getreg((3 << 11) | 20) & 0xFu; }
#define XB_SPIN(cond, bar) do { unsigned _sp = 0; while (cond) { __builtin_amdgcn_s_sleep(1); \
    if ((++_sp & 255u) == 0u) { if (xb_ld(&(bar)[XB_TMO])) break; if (_sp > XB_SPIN_CAP) { atomicAdd(&(bar)[XB_TMO], 1u); break; } } } } while (0)
struct XcdBarrier { unsigned* bar; unsigned x; volatile LAS unsigned* st; };
__device__ __forceinline__ XcdBarrier xcd_barrier_post(unsigned* bar, volatile LAS unsigned* st) {
    XcdBarrier b; b.bar = bar; b.x = xb_xcc_id(); b.st = st;
    if (threadIdx.x == 0) (void)xb_add(&bar[XB_XCNT(b.x)], 1u);
    return b;
}
__device__ __forceinline__ void xcd_barrier_complete(unsigned* bar, unsigned x, unsigned& nloc, unsigned& nx);
__device__ __forceinline__ void xcd_barrier_census(const XcdBarrier& b) {
    if (threadIdx.x == 0) { unsigned nloc, nx; xcd_barrier_complete(b.bar, b.x, nloc, nx); b.st[0] = nloc; b.st[1] = nx; }
    __syncthreads();
}
__device__ __forceinline__ void xcd_barrier_complete(unsigned* bar, unsigned x, unsigned& nloc, unsigned& nx) {
    const unsigned G = gridDim.x * gridDim.y * gridDim.z;
    unsigned sum, cnt, mine, sp = 0u;
    for (;;) {
        sum = 0u; cnt = 0u; mine = 0u;
#pragma unroll
        for (unsigned j = 0; j < 16; ++j) { const unsigned c = xb_ld(&bar[XB_XCNT(j)]); sum += c; cnt += (c > 0u) ? 1u : 0u; mine = (j == x) ? c : mine; }
        if (sum == G) break;
        __builtin_amdgcn_s_sleep(1);
        if ((++sp & 255u) == 0u) { if (xb_ld(&bar[XB_TMO])) break; if (sp > XB_SPIN_CAP) { atomicAdd(&bar[XB_TMO], 1u); break; } }
    }
    nloc = mine > 0u ? mine : 1u; nx = cnt > 0u ? cnt : 1u;
}
__device__ __forceinline__ void xcd_barrier(const XcdBarrier& b) {
    asm volatile("s_waitcnt vmcnt(0)" ::: "memory");
    __syncthreads();
    if (threadIdx.x == 0) {
        unsigned* bar = b.bar;
        __builtin_amdgcn_s_waitcnt(0);
        const unsigned nloc = b.st[0], nx = b.st[1];
        const unsigned old = xb_add(&bar[XB_XSUB(b.x)], 1u);
        const unsigned gen = old / nloc;
        if (old + 1u == (gen + 1u) * nloc) {
            __builtin_amdgcn_fence(__ATOMIC_RELEASE, "agent");
            asm volatile("s_waitcnt vmcnt(0)" ::: "memory");
            const unsigned og = xb_add(&bar[XB_TOP], 1u);
            const unsigned tg = og / nx;
            if (og + 1u == (tg + 1u) * nx) xb_add(&bar[XB_TOPGEN], 1u);
            else XB_SPIN(xb_ld(&bar[XB_TOPGEN]) == tg, bar);
            __builtin_amdgcn_fence(__ATOMIC_ACQUIRE, "agent");
            xb_add(&bar[XB_XGEN(b.x)], 1u);
            asm volatile("s_waitcnt vmcnt(0)" ::: "memory");
        } else {
            XB_SPIN(xb_ld(&bar[XB_XGEN(b.x)]) == gen, bar);
            __builtin_amdgcn_fence(__ATOMIC_ACQUIRE, "agent");
            asm volatile("s_waitcnt vmcnt(0)" ::: "memory");
        }
    }
    __syncthreads();
}

__global__ void __launch_bounds__(512, 2) hybrid_fwd(Args args) {
    extern __shared__ __attribute__((aligned(16))) unsigned char lds_raw[];
    LAS unsigned char* lds = (LAS unsigned char*)lds_raw;
    cg::grid_group grid = cg::this_grid();
    unsigned char* ws = args.ws;
    const int lo = args.ph_lo, hi = args.ph_hi, G = gridDim.x, c = blockIdx.x;
    const char* XB = (const char*)(ws + WS_XB); bf16_t* PROJ = (bf16_t*)(ws + WS_PROJ); float* SSQ = (float*)(ws + WS_SSQ);
#ifndef PH_MASK
#define PH_MASK 0xffff
#endif
#define IN(k) (((PH_MASK >> (k)) & 1) && lo <= (k) && (k) < hi)
    volatile LAS unsigned* bst = (volatile LAS unsigned*)(lds + EPI_LDS_OFF + 8192);
    if (threadIdx.x < 2) bst[threadIdx.x] = 0u;
    __syncthreads();
    XcdBarrier xbar; xbar.bar = (unsigned*)(ws + WS_CTL); xbar.x = 0; xbar.st = bst;
    if (hi - lo > 1) {
        if (c == 0) { unsigned* ctl = (unsigned*)(ws + WS_CTL);
            for (int i = threadIdx.x; i < (int)(CTL_BYTES / 4); i += 512) __hip_atomic_store(&ctl[i], 0u, __ATOMIC_RELAXED, __HIP_MEMORY_SCOPE_AGENT);
            __threadfence(); }
        grid.sync();
        xbar = xcd_barrier_post((unsigned*)(ws + WS_CTL), bst); xcd_barrier_census(xbar); }
#define SEAM(k) do { if (IN(k) && IN((k) + 1)) { xcd_barrier(xbar); } } while (0)
    const int GC = G >= 64 ? G - 16 : G;
    {
        int npass = 2; asm volatile("" : "+s"(npass));
#pragma nounroll
        for (int pass = 0; pass < npass; ++pass) {
            const bool run = pass == 0 ? IN(0) : (IN(1) && (c >= GC || GC == G));
            if (run) { const int wv = threadIdx.x >> 6;
                prep_items(args, lds, pass ? PREP_EARLY : 0, pass ? PREP_NITEMS : PREP_EARLY, pass && GC != G ? (c - GC) * 8 + wv : c * 8 + wv, pass && GC != G ? (G - GC) * 8 : G * 8); __syncthreads(); }
            if (pass == 0) { if (IN(0)) phase_prep_rows(args); SEAM(0); }
        }
    }
    if (IN(1)) {
        SchedUpKV S; S.o.init(T / 256, 5632 / 256, GC, c); S.ws = (const char*)ws; S.offA = WS_XB; S.offB = W_1C1;
        EpiSwiGLU E{(bf16_t*)(ws + WS_H), SSQ, (bf16_t*)(ws + WS_KV)};
        if (c < GC || GC == G) pg8::gemm_phase(lds, 1024, 1024, 1024, S, E);
    } SEAM(1);
    if (IN(2)) {
        SchedPlain S; S.o.init(T / 256, 4, G, c); S.A = (const char*)(ws + WS_H); S.B = (const char*)(ws + W_21); S.ta = (size_t)256 * FF * 2; S.tb = (size_t)256 * FF * 2;
        EpiResid E{(bf16_t*)(ws + WS_XB), SSQ, 0.5f};
        pg8::gemm_phase(lds, FF, FF, FF, S, E);
    } SEAM(2);
    if (IN(3)) {
        SchedPlain S; S.o.init(T / 256, NPROJ / 256, G, c); S.A = XB; S.B = (const char*)(ws + W_IN); S.ta = (size_t)256 * 1024 * 2; S.tb = (size_t)256 * 1024 * 2;
        EpiScaleBf16<true> E{PROJ, NPROJ, SSQ};
        pg8::gemm_phase(lds, 1024, 1024, 1024, S, E);
        phase_acode(args);
    } SEAM(3);
    if (IN(4)) { gla_units<0>(args, lds); phase_pool(args); prep_late(args, lds); } SEAM(4);
    if (IN(5)) {
        phase_gla_scan(args);
        SchedPlain S; S.o.init(T / 256, 4, G, c); S.A = (const char*)args.out; S.B = (const char*)(ws + W_PB); S.ta = (size_t)256 * 512 * 2; S.tb = (size_t)256 * 512 * 2;
        EpiYB E{PROJ};
        pg8::gemm_phase(lds, 512, 512, 512, S, E);
        {
            SchedPre P; P.G = G; P.c = c; P.mode = 0; P.KV = (const char*)(ws + WS_KV); P.W = (const char*)(ws + W_Q);
            EpiPre EP{(bf16_t*)(ws + WS_WQK), 0};
            pg8::gemm_phase(lds, 256, 2048, 1024, P, EP);
        }
        {
            SchedPre P; P.G = G; P.c = (c + G / 2) % G; P.mode = 1; P.KV = (const char*)(ws + WS_KV); P.W = (const char*)(ws + W_O);
            EpiPre EP{(bf16_t*)(ws + WS_VWOT), 1};
            pg8::gemm_phase(lds, 256, 1024, 2048, P, EP);
        }
    } SEAM(5);
    if (IN(6)) { gla_units<1>(args, lds); } SEAM(6);
    if (IN(7)) {
        SchedPlain S; S.o.init(T / 256, 4, G, c); S.A = (const char*)(PROJ + PV0); S.B = (const char*)(ws + W_UPA); S.ta = (size_t)256 * NPROJ * 2; S.tb = (size_t)256 * 1024 * 2;
        EpiMG E{PROJ};
        pg8::gemm_phase(lds, 1024, NPROJ, 1024, S, E);
    } SEAM(7);
    if (IN(8)) {
        SchedPlain S; S.o.init(T / 256, 4, G, c); S.A = (const char*)(PROJ + PGA0); S.B = (const char*)(ws + W_MIX); S.ta = (size_t)256 * NPROJ * 2; S.tb = (size_t)256 * 1024 * 2;
        EpiResid E{(bf16_t*)(ws + WS_XB), SSQ, 1.0f};
        pg8::gemm_phase(lds, 1024, NPROJ, 1024, S, E);
    } SEAM(8);
    if (IN(9)) {
        SchedAttn S; S.G = G; S.c = c; S.A = XB; S.B = (const char*)(ws + WS_WQK);
        EpiSoftmax E{(bf16_t*)(ws + WS_PR), (LAS float*)(lds + EPI_LDS_OFF), SSQ};
        pg8::gemm_phase(lds, 1024, 1024, 1024, S, E);
    } SEAM(9);
    if (IN(10)) {
        SchedAttn S; S.G = G; S.c = c; S.A = (const char*)(ws + WS_PR); S.B = (const char*)(ws + WS_VWOT);
        EpiResid E{(bf16_t*)(ws + WS_XB), SSQ, 1.0f};
        pg8::gemm_phase(lds, 1024, 1024, 1024, S, E);
    } SEAM(10);
    if (IN(11)) {
        SchedPlain S2; S2.o.init(T / 256, 5632 / 256, G, c); S2.A = XB; S2.B = (const char*)(ws + W_1C2); S2.ta = (size_t)256 * 1024 * 2; S2.tb = (size_t)256 * 1024 * 2;
        EpiSwiGLU E{(bf16_t*)(ws + WS_H), SSQ, nullptr};
        pg8::gemm_phase(lds, 1024, 1024, 1024, S2, E);
    } SEAM(11);
    if (IN(12)) {
        SchedPlain S; S.o.init(T / 256, 4, G, c); S.A = (const char*)(ws + WS_H); S.B = (const char*)(ws + W_22); S.ta = (size_t)256 * FF * 2; S.tb = (size_t)256 * FF * 2;
        EpiResid E{(bf16_t*)(ws + WS_XB), SSQ, 0.5f};
        pg8::gemm_phase(lds, FF, FF, FF, S, E);
    } SEAM(12);
    if (IN(13)) { phase_final(args); }
#undef IN
#undef SEAM
}

extern "C" void kernel_launch(void* const* d_in, const int* in_sizes, int n_in, void* d_out, int out_size, void* d_ws, size_t ws_size, hipStream_t stream) {
    static int grid = 0;
    if (grid == 0) {
        if (n_in != 27 || out_size != T * D || ws_size < WS_VWOT + 16 * MiB) { fprintf(stderr, "kernel_launch: unexpected problem (n_in %d out %d ws %zu, need ws >= %zu)\n", n_in, out_size, ws_size, (size_t)(WS_VWOT + 16 * MiB)); grid = -1; return; }
        int dev = 0, cus = 0, per_cu = 0;
        (void)hipGetDevice(&dev); (void)hipDeviceGetAttribute(&cus, hipDeviceAttributeMultiprocessorCount, dev);
        if (hipFuncSetAttribute((const void*)hybrid_fwd, hipFuncAttributeMaxDynamicSharedMemorySize, LDS_BYTES) != hipSuccess) { fprintf(stderr, "kernel_launch: hipFuncSetAttribute failed\n"); grid = -1; return; }
        (void)hipOccupancyMaxActiveBlocksPerMultiprocessor(&per_cu, (const void*)hybrid_fwd, 512, LDS_BYTES);
        (void)hipGetLastError();
        if (per_cu < 1) per_cu = 1;
        grid = cus * per_cu;
    }
    if (grid < 0) return;
    Args a{};
    for (int i = 0; i < 27; ++i) a.in[i] = (const float*)d_in[i];
    a.out = (float*)d_out; a.ws = (unsigned char*)d_ws;
#if MK_ONE_LAUNCH
    a.ph_lo = 0; a.ph_hi = NPHASE;
    void* kargs[] = {&a};
    hipError_t e = hipLaunchCooperativeKernel((const void*)hybrid_fwd, dim3(grid), dim3(512), kargs, LDS_BYTES, stream);
    if (e != hipSuccess) fprintf(stderr, "cooperative launch failed: %s (grid %d)\n", hipGetErrorString(e), grid);
#else
    for (int p = 0; p < NPHASE; ++p) { a.ph_lo = p; a.ph_hi = p + 1; hipLaunchKernelGGL(hybrid_fwd, dim3(grid), dim3(512), LDS_BYTES, stream, a); }
#endif
}
```

```cpp
#include <hip/hip_runtime.h>
#include <hip/hip_cooperative_groups.h>
#include <cstdio>
#include <cstdint>
namespace cg = cooperative_groups;

#ifndef MK_ONE_LAUNCH
#define MK_ONE_LAUNCH 1
#endif

#define LAS __attribute__((address_space(3)))
typedef unsigned short bf16_t;
typedef short bf16x8 __attribute__((ext_vector_type(8)));
typedef short bf16x4 __attribute__((ext_vector_type(4)));
typedef float f32x4 __attribute__((ext_vector_type(4)));
typedef float f32x2 __attribute__((ext_vector_type(2)));
typedef unsigned u32x4 __attribute__((ext_vector_type(4)));
typedef unsigned u32x2 __attribute__((ext_vector_type(2)));

constexpr int T = 32768, D = 1024, FF = 2816, SEQ = 4096, NBATCH = 8, MEMLEN = 256;
constexpr int NPROJ = 5632;
constexpr int PQ0 = 0, PK0 = 512, PV0 = 1024, PR0 = 2048, PU0 = 3072, PGA0 = 3584, PGB0 = 4608;
constexpr int WIN_LD = 5648;
constexpr float EPS = 1e-6f;
constexpr int NPHASE = 14;

constexpr size_t MiB = 1u << 20;
constexpr size_t WS_SSQ = 0, WS_ACODE = 2 * MiB, WS_LDG = 4 * MiB, WS_KV = 5 * MiB, WS_MB = 13 * MiB;
constexpr size_t WS_CTL = 18 * MiB, CTL_BYTES = 16384;
constexpr size_t WS_W = 20 * MiB;
constexpr size_t W_1C1 = WS_W, W_21 = W_1C1 + (size_t)5632 * 1024 * 2, W_IN = W_21 + (size_t)1024 * 2816 * 2, W_AT = W_IN + (size_t)5632 * 1024 * 2,
                 W_UPA = W_AT + 32768, W_PB = W_UPA + 2 * MiB, W_MIX = W_PB + MiB, W_Q = W_MIX + 2 * MiB, W_KV = W_Q + 2 * MiB, W_O = W_KV + 4 * MiB,
                 W_1C2 = W_O + 2 * MiB, W_22 = W_1C2 + (size_t)5632 * 1024 * 2, W_END = W_22 + (size_t)1024 * 2816 * 2;
static_assert(W_END <= 80 * MiB && W_IN >= W_1C1 + 16 * MiB, "weight region");
constexpr size_t WS_XB = 80 * MiB, WS_PB = 80 * MiB, WS_STG = 112 * MiB;
constexpr size_t WS_PROJ = 144 * MiB, WS_H = WS_PROJ, WS_PR = WS_PROJ + 64 * MiB;
constexpr size_t WS_VWOT = 496 * MiB;
constexpr size_t WS_WQK = W_1C1;
constexpr size_t WS_END = WS_PROJ + (size_t)T * NPROJ * 2;
static_assert(WS_END <= 512 * MiB, "d_ws map");

constexpr int RING_BYTES = 131072, EPI_LDS_OFF = RING_BYTES, LDS_BYTES = 147456;

__device__ __forceinline__ unsigned f2bf(float f) { unsigned u = __builtin_bit_cast(unsigned, f); return (u + 0x7fffu + ((u >> 16) & 1u)) >> 16; }
__device__ __forceinline__ unsigned pk2(float lo, float hi) { unsigned r; asm("v_cvt_pk_bf16_f32 %0, %1, %2" : "=v"(r) : "v"(lo), "v"(hi)); return r; }
__device__ __forceinline__ unsigned pk2m(float lo, float hi) { return f2bf(lo) | (f2bf(hi) << 16); }
__device__ __forceinline__ float bf2f(unsigned short b) { return __builtin_bit_cast(float, (unsigned)b << 16); }
__device__ __forceinline__ float bflo(unsigned w) { return __builtin_bit_cast(float, w << 16); }
__device__ __forceinline__ float bfhi(unsigned w) { return __builtin_bit_cast(float, w & 0xffff0000u); }
__device__ __forceinline__ float sigmoidf_(float x) { return __builtin_amdgcn_rcpf(1.f + __expf(-x)); }
__device__ __forceinline__ float siluf_(float x) { return x * sigmoidf_(x); }
__device__ __forceinline__ float wave_sum(float v) {
#pragma unroll
    for (int o = 1; o < 64; o <<= 1) v += __shfl_xor(v, o);
    return v;
}
#define LDS_WAIT() asm volatile("s_waitcnt lgkmcnt(0)" ::: "memory")

namespace pg8 {
constexpr int BM = 256, BK = 64, HALF = 128, HTB = HALF * BK * 2, NXCD = 8, WGM = 8;
__host__ __device__ __forceinline__ int lds_byte(int r, int c) { const int st = (r >> 4) * 2 + (c >> 5), rr = r & 15, cc = c & 31, ob = rr * 64 + cc * 2; return st * 1024 + (ob ^ (((ob >> 9) & 1) << 5)); }
__host__ __device__ __forceinline__ void stage_rc(int b, int& R, int& C) { const int st = b / 1024, sb = b % 1024, swz = sb ^ (((sb >> 9) & 1) << 5); R = (st >> 1) * 16 + swz / 64; C = (st & 1) * 32 + (swz % 64) / 2; }
__host__ __device__ __forceinline__ int perm32(int rho) { const int n = rho >> 4, i = rho & 15; return 8 * (i >> 2) + 4 * n + (i & 3); }

struct Unit { int pm, pn, kind; };

struct GridOrder {
    int nM, nN, nwg, G, c;
    __device__ __forceinline__ void init(int nM_, int nN_, int G_, int c_) { nM = nM_; nN = nN_; nwg = nM * nN; G = G_; c = c_; }
    __device__ __forceinline__ bool map(int L, Unit& u) const {
        if (L >= nwg) return false;
        int wgid = L; { const int q = nwg / NXCD, r = nwg % NXCD, xcd = wgid % NXCD, off = wgid / NXCD; wgid = (xcd < r ? xcd * (q + 1) : r * (q + 1) + (xcd - r) * q) + off; }
        const int nig = WGM * nN, gid = wgid / nig, fm = gid * WGM, gsz = (nM - fm) < WGM ? (nM - fm) : WGM;
        u.pm = fm + ((wgid % nig) % gsz); u.pn = (wgid % nig) / gsz; u.kind = 0; return true;
    }
};

template <class Epi, class Sched>
__device__ __forceinline__ void gemm_phase(LAS unsigned char* lds, const int K, const int lda, const int ldb, const Sched& S, const Epi& E) {
    const int tid = threadIdx.x, wid = __builtin_amdgcn_readfirstlane(tid >> 6), lane = tid & 63, wr = wid >> 2, wc = wid & 3, fr = lane & 15, fq = lane >> 4;
    int nt = K / BK; asm volatile("" : "+s"(nt));
    unsigned voffA[2], voffB[2];
#pragma unroll
    for (int i = 0; i < 2; ++i) { int R, C; stage_rc(tid * 16 + i * 8192, R, C); const int Rb = Epi::PERM ? ((R & ~31) + perm32(R & 31)) : R;
        voffA[i] = (unsigned)(R * lda + C) * 2u; voffB[i] = (unsigned)(Rb * ldb + C) * 2u; }
    const size_t kstep = (size_t)(BK * 2);
    const size_t hstepA = (size_t)HALF * lda * 2, hstepB = (size_t)HALF * ldb * 2;
    const unsigned ldsw = (unsigned)wid * 1024u;
    const int aoff = lds_byte(wr * 64 + fr, fq * 8), boff = lds_byte(wc * 32 + fr, fq * 8);
#define PG8_SA(b, h) (((b) * 2 + (h)) * HTB)
#define PG8_SB(b, h) ((4 + (b) * 2 + (h)) * HTB)
#define PG8_STAGE(bufoff, gbase, voff) do { _Pragma("unroll") for (int _i = 0; _i < 2; ++_i) \
        __builtin_amdgcn_global_load_lds((const unsigned*)((const char*)(gbase) + (voff)[_i]), (LAS unsigned*)(lds + (bufoff) + ldsw + _i * 8192), 16, 0, 0); } while (0)
#define PG8_LDA(dst, b, h) do { _Pragma("unroll") for (int m = 0; m < 4; ++m) _Pragma("unroll") for (int k = 0; k < 2; ++k) dst[m][k] = *(const LAS bf16x8*)(lds + PG8_SA(b, h) + aoff + m * 2048 + k * 1024); } while (0)
#define PG8_LDB(dst, b, h) do { _Pragma("unroll") for (int n = 0; n < 2; ++n) _Pragma("unroll") for (int k = 0; k < 2; ++k) dst[n][k] = *(const LAS bf16x8*)(lds + PG8_SB(b, h) + boff + n * 2048 + k * 1024); } while (0)
#define PG8_MMA(ai, bj, At, Bt) do { __builtin_amdgcn_s_setprio(1); _Pragma("unroll") for (int m = 0; m < 4; ++m) _Pragma("unroll") for (int n = 0; n < 2; ++n) _Pragma("unroll") for (int k = 0; k < 2; ++k) \
        acc[ai][bj][m][n] = __builtin_amdgcn_mfma_f32_16x16x32_bf16(Bt[n][k], At[m][k], acc[ai][bj][m][n], 0, 0, 0); __builtin_amdgcn_s_setprio(0); } while (0)
#define PG8_WAIT_V(n) asm volatile("s_waitcnt vmcnt(" #n ")" ::: "memory")
#define PG8_WAIT_L(n) asm volatile("s_waitcnt lgkmcnt(" #n ")" ::: "memory")
#define PG8_BAR __builtin_amdgcn_s_barrier()
#define PG8_SCHED __builtin_amdgcn_sched_barrier(0)
    Unit cur, nxt; int ui = 0;
    if (!S.next(0, cur)) return;
    f32x4 acc[2][2][4][2];
#pragma unroll
    for (int a = 0; a < 2; ++a)
#pragma unroll
        for (int b = 0; b < 2; ++b)
#pragma unroll
            for (int m = 0; m < 4; ++m)
#pragma unroll
                for (int n = 0; n < 2; ++n) acc[a][b][m][n] = (f32x4){0.f, 0.f, 0.f, 0.f};
    bf16x8 At[4][2], B0[2][2], B1[2][2];
    const char* cA = S.a(cur); const char* cB = S.b(cur);
    PG8_STAGE(PG8_SB(0, 0), cB, voffB); PG8_STAGE(PG8_SB(0, 1), cB + hstepB, voffB); PG8_STAGE(PG8_SA(0, 0), cA, voffA); PG8_STAGE(PG8_SA(0, 1), cA + hstepA, voffA);
    if (wr == 1) PG8_BAR;
    PG8_WAIT_V(2); PG8_BAR;
    PG8_STAGE(PG8_SB(1, 0), cB + kstep, voffB); PG8_STAGE(PG8_SA(1, 0), cA + kstep, voffA); PG8_STAGE(PG8_SB(1, 1), cB + hstepB + kstep, voffB);
    PG8_WAIT_V(6); PG8_BAR;
    for (;;) {
        const bool has_next = S.next(ui + 1, nxt);
        const char* nA = has_next ? S.a(nxt) : cA; const char* nB = has_next ? S.b(nxt) : cB;
        for (int t = 0; t < nt; t += 2) {
            const bool last = (t == nt - 2);
            const char* a1 = cA + (size_t)(t + 1) * kstep;
            const char* a2 = last ? nA : cA + (size_t)(t + 2) * kstep; const char* b2 = last ? nB : cB + (size_t)(t + 2) * kstep;
            const char* a3 = a2 + kstep; const char* b3 = b2 + kstep;
            PG8_LDB(B0, 0, 0); PG8_LDB(B1, 0, 1); PG8_SCHED; PG8_LDA(At, 0, 0); PG8_STAGE(PG8_SA(1, 1), a1 + hstepA, voffA);
            PG8_WAIT_V(8); PG8_WAIT_L(0); PG8_BAR; PG8_MMA(0, 0, At, B0); PG8_MMA(0, 1, At, B1); PG8_BAR; PG8_SCHED;
            PG8_LDA(At, 0, 1); PG8_STAGE(PG8_SB(0, 0), b2, voffB); PG8_STAGE(PG8_SB(0, 1), b2 + hstepB, voffB); PG8_STAGE(PG8_SA(0, 0), a2, voffA);
            PG8_WAIT_V(8); PG8_WAIT_L(0); PG8_BAR; PG8_MMA(1, 0, At, B0); PG8_MMA(1, 1, At, B1); PG8_BAR; PG8_SCHED;
            PG8_LDB(B0, 1, 0); PG8_LDB(B1, 1, 1); PG8_SCHED; PG8_LDA(At, 1, 0); PG8_STAGE(PG8_SA(0, 1), a2 + hstepA, voffA);
            PG8_WAIT_V(8); PG8_WAIT_L(0); PG8_BAR; PG8_MMA(0, 0, At, B0); PG8_MMA(0, 1, At, B1); PG8_BAR; PG8_SCHED;
            PG8_LDA(At, 1, 1); PG8_STAGE(PG8_SB(1, 0), b3, voffB); PG8_STAGE(PG8_SB(1, 1), b3 + hstepB, voffB); PG8_STAGE(PG8_SA(1, 0), a3, voffA);
            PG8_WAIT_V(8); PG8_WAIT_L(0); PG8_BAR; PG8_MMA(1, 0, At, B0); PG8_MMA(1, 1, At, B1); PG8_BAR; PG8_SCHED;
        }
        if (wr == 0) PG8_BAR;
        E(acc, cur, wr, wc, fr, fq);
        if (!has_next) break;
#pragma unroll
        for (int a = 0; a < 2; ++a)
#pragma unroll
            for (int b = 0; b < 2; ++b)
#pragma unroll
                for (int m = 0; m < 4; ++m)
#pragma unroll
                    for (int n = 0; n < 2; ++n) acc[a][b][m][n] = (f32x4){0.f, 0.f, 0.f, 0.f};
        cur = nxt; cA = nA; cB = nB; ++ui;
        if (wr == 1) PG8_BAR;
    }
    PG8_WAIT_V(0);
    PG8_BAR;
#undef PG8_SA
#undef PG8_SB
#undef PG8_STAGE
#undef PG8_LDA
#undef PG8_LDB
#undef PG8_MMA
#undef PG8_WAIT_V
#undef PG8_WAIT_L
#undef PG8_SCHED
}
}
using pg8::Unit;
typedef f32x4 Acc[2][2][4][2];

struct SchedPlain {
    pg8::GridOrder o; const char* A; const char* B; size_t ta, tb;
    __device__ __forceinline__ bool next(int i, Unit& u) const { return o.map(i * o.G + o.c, u); }
    __device__ __forceinline__ const char* a(const Unit& u) const { return A + (size_t)u.pm * ta; }
    __device__ __forceinline__ const char* b(const Unit& u) const { return B + (size_t)u.pn * tb; }
};
struct SchedUpKV {
    pg8::GridOrder o; const char* ws; size_t offA, offB;
    __device__ __forceinline__ bool next(int i, Unit& u) const { const int L = i * o.G + o.c; if (L < o.nwg) return o.map(L, u); const int r = L - o.nwg; if (r >= 64) return false;
        u.pm = r & 7; u.pn = r >> 3; u.kind = 1; return true; }
    __device__ __forceinline__ const char* a(const Unit& u) const { return ws + (u.kind == 0 ? offA : WS_MB) + (size_t)u.pm * (256 * 1024 * 2); }
    __device__ __forceinline__ const char* b(const Unit& u) const { return ws + (u.kind == 0 ? offB : W_KV) + (size_t)u.pn * (256 * 1024 * 2); }
};
struct SchedAttn {
    int G, c; const char* A; const char* B;
    __device__ __forceinline__ bool next(int i, Unit& u) const { const int L = i * G + c; if (L >= 512) return false; u.pm = L >> 2; u.pn = L & 3; u.kind = 0; return true; }
    __device__ __forceinline__ const char* a(const Unit& u) const { return A + (size_t)u.pm * (256 * 1024 * 2); }
    __device__ __forceinline__ const char* b(const Unit& u) const { return B + (size_t)(u.pm >> 4) * (2 * MiB) + (size_t)u.pn * (256 * 1024 * 2); }
};
struct SchedPre {
    int G, c, mode; const char* KV; const char* W;
    __device__ __forceinline__ bool next(int i, Unit& u) const { const int L = i * G + c; if (L >= 128) return false; u.pm = L >> 2; u.pn = L & 3; u.kind = 0; return true; }
    __device__ __forceinline__ const char* kv(const Unit& u) const { return KV + (size_t)(u.pm >> 2) * (256 * 2048 * 2) + (mode ? 2048 : 0) + (size_t)(u.pm & 3) * 512; }
    __device__ __forceinline__ const char* w(const Unit& u) const { return W + (size_t)u.pn * (256 * 1024 * 2) + (size_t)(u.pm & 3) * 512; }
    __device__ __forceinline__ const char* a(const Unit& u) const { return mode ? w(u) : kv(u); }
    __device__ __forceinline__ const char* b(const Unit& u) const { return mode ? kv(u) : w(u); }
};

__device__ __forceinline__ float row_rs(const float* ssq, int row) {
    const f32x4* p = (const f32x4*)(ssq + (size_t)row * 16);
    const f32x4 a = p[0], b = p[1], c = p[2], d = p[3];
    const float s = ((a[0] + a[1]) + (a[2] + a[3])) + ((b[0] + b[1]) + (b[2] + b[3])) + ((c[0] + c[1]) + (c[2] + c[3])) + ((d[0] + d[1]) + (d[2] + d[3]));
    return __builtin_amdgcn_rsqf(s * (1.0f / D) + EPS);
}
__device__ __forceinline__ float row_rs4(const float* ssq, int row, int fq) {
    const f32x4 a = *(const f32x4*)(ssq + (size_t)row * 16 + 4 * fq);
    float s = (a[0] + a[1]) + (a[2] + a[3]);
    s += __shfl_xor(s, 16); s += __shfl_xor(s, 32);
    return __builtin_amdgcn_rsqf(s * (1.0f / D) + EPS);
}
__device__ __forceinline__ void rows_rs(const float* ssq, int row0, int fq, float (&rr)[2][4]) {
    f32x4 p[2][4];
#pragma unroll
    for (int ai = 0; ai < 2; ++ai)
#pragma unroll
        for (int m = 0; m < 4; ++m) p[ai][m] = *(const f32x4*)(ssq + (size_t)(row0 + ai * 128 + m * 16) * 16 + 4 * fq);
    asm volatile("" ::: "memory");
#pragma unroll
    for (int ai = 0; ai < 2; ++ai)
#pragma unroll
        for (int m = 0; m < 4; ++m) { float s = (p[ai][m][0] + p[ai][m][1]) + (p[ai][m][2] + p[ai][m][3]); s += __shfl_xor(s, 16); s += __shfl_xor(s, 32); rr[ai][m] = __builtin_amdgcn_rsqf(s * (1.0f / D) + EPS); }
}
__device__ __forceinline__ u32x4 pack8(const f32x4 v0, const f32x4 v1) { u32x4 w; w.x = pk2(v0[0], v0[1]); w.y = pk2(v0[2], v0[3]); w.z = pk2(v1[0], v1[1]); w.w = pk2(v1[2], v1[3]); return w; }

struct EpiSwiGLU {
    static constexpr bool PERM = true;
    bf16_t* H; const float* ssq; bf16_t* KV;
    __device__ __forceinline__ void operator()(Acc& acc, const Unit& u, int wr, int wc, int fr, int fq) const {
        if (u.kind == 0) {
            float rr[2][4]; rows_rs(ssq, u.pm * 256 + wr * 64 + fr, fq, rr);
#pragma unroll
            for (int ai = 0; ai < 2; ++ai)
#pragma unroll
                for (int m = 0; m < 4; ++m) {
                    const int row = u.pm * 256 + ai * 128 + wr * 64 + m * 16 + fr; const float r = rr[ai][m];
                    f32x4 h0, h1;
#pragma unroll
                    for (int j = 0; j < 4; ++j) { h0[j] = siluf_(acc[ai][0][m][0][j] * r) * (acc[ai][1][m][0][j] * r); h1[j] = siluf_(acc[ai][0][m][1][j] * r) * (acc[ai][1][m][1][j] * r); }
                    *(u32x4*)(H + (size_t)row * FF + u.pn * 128 + wc * 32 + 8 * fq) = pack8(h0, h1);
                }
        } else {
            bf16_t* base = KV + (size_t)(u.pm * 256) * 2048 + u.pn * 256;
#pragma unroll
            for (int ai = 0; ai < 2; ++ai)
#pragma unroll
                for (int m = 0; m < 4; ++m) { const int rl = ai * 128 + wr * 64 + m * 16 + fr;
#pragma unroll
                    for (int bj = 0; bj < 2; ++bj) *(u32x4*)(base + (size_t)rl * 2048 + bj * 128 + wc * 32 + 8 * fq) = pack8(acc[ai][bj][m][0], acc[ai][bj][m][1]); }
        }
    }
};
struct EpiPre {
    static constexpr bool PERM = true;
    bf16_t* O; int mode;
    __device__ __forceinline__ void operator()(Acc& acc, const Unit& u, int wr, int wc, int fr, int fq) const {
        bf16_t* base = O + (size_t)(u.pm >> 2) * 1048576 + (mode ? (size_t)(u.pn * 256) * 1024 + (u.pm & 3) * 256 : (size_t)((u.pm & 3) * 256) * 1024 + u.pn * 256);
#pragma unroll
        for (int ai = 0; ai < 2; ++ai)
#pragma unroll
            for (int m = 0; m < 4; ++m) { const int rl = ai * 128 + wr * 64 + m * 16 + fr;
#pragma unroll
                for (int bj = 0; bj < 2; ++bj) *(u32x4*)(base + (size_t)rl * 1024 + bj * 128 + wc * 32 + 8 * fq) = pack8(acc[ai][bj][m][0], acc[ai][bj][m][1]); }
    }
};
struct EpiResid {
    static constexpr bool PERM = true;
    bf16_t* xb; float* ssq; float alpha;
    __device__ __forceinline__ void operator()(Acc& acc, const Unit& u, int wr, int wc, int fr, int fq) const {
#pragma unroll
        for (int ai = 0; ai < 2; ++ai)
#pragma unroll
            for (int m = 0; m < 4; ++m) {
                const int row = u.pm * 256 + ai * 128 + wr * 64 + m * 16 + fr; float ss = 0.f;
#pragma unroll
                for (int bj = 0; bj < 2; ++bj) { bf16_t* p = xb + (size_t)row * D + u.pn * 256 + bj * 128 + wc * 32 + 8 * fq; const u32x4 b = *(const u32x4*)p;
                    f32x4 o0, o1; o0[0] = bflo(b.x); o0[1] = bfhi(b.x); o0[2] = bflo(b.y); o0[3] = bfhi(b.y); o1[0] = bflo(b.z); o1[1] = bfhi(b.z); o1[2] = bflo(b.w); o1[3] = bfhi(b.w);
                    o0 = o0 + acc[ai][bj][m][0] * alpha; o1 = o1 + acc[ai][bj][m][1] * alpha;
                    ss += ((o0[0] * o0[0] + o0[1] * o0[1]) + (o0[2] * o0[2] + o0[3] * o0[3])) + ((o1[0] * o1[0] + o1[1] * o1[1]) + (o1[2] * o1[2] + o1[3] * o1[3]));
                    *(u32x4*)p = pack8(o0, o1); }
                ss += __shfl_xor(ss, 16); ss += __shfl_xor(ss, 32);
                if (fq == 0) ssq[(size_t)row * 16 + u.pn * 4 + wc] = ss;
            }
    }
};
template <bool USE_R> struct EpiScaleBf16 {
    static constexpr bool PERM = true;
    bf16_t* O; int ldc; const float* ssq;
    __device__ __forceinline__ void operator()(Acc& acc, const Unit& u, int wr, int wc, int fr, int fq) const {
        float rr[2][4]; if (USE_R) rows_rs(ssq, u.pm * 256 + wr * 64 + fr, fq, rr);
#pragma unroll
        for (int ai = 0; ai < 2; ++ai)
#pragma unroll
            for (int m = 0; m < 4; ++m) { const int row = u.pm * 256 + ai * 128 + wr * 64 + m * 16 + fr; const float r = USE_R ? rr[ai][m] : 1.f;
#pragma unroll
                for (int bj = 0; bj < 2; ++bj) *(u32x4*)(O + (size_t)row * ldc + u.pn * 256 + bj * 128 + wc * 32 + 8 * fq) = pack8(acc[ai][bj][m][0] * r, acc[ai][bj][m][1] * r); }
    }
};
struct EpiYB {
    static constexpr bool PERM = true;
    bf16_t* proj;
    __device__ __forceinline__ void operator()(Acc& acc, const Unit& u, int wr, int wc, int fr, int fq) const {
#pragma unroll
        for (int ai = 0; ai < 2; ++ai)
#pragma unroll
            for (int m = 0; m < 4; ++m) { const int row = u.pm * 256 + ai * 128 + wr * 64 + m * 16 + fr;
#pragma unroll
                for (int bj = 0; bj < 2; ++bj) { bf16_t* p = proj + (size_t)row * NPROJ + PGB0 + u.pn * 256 + bj * 128 + wc * 32 + 8 * fq; const u32x4 g = *(const u32x4*)p;
                    f32x4 v0, v1; v0[0] = sigmoidf_(bflo(g.x)); v0[1] = sigmoidf_(bfhi(g.x)); v0[2] = sigmoidf_(bflo(g.y)); v0[3] = sigmoidf_(bfhi(g.y));
                    v1[0] = sigmoidf_(bflo(g.z)); v1[1] = sigmoidf_(bfhi(g.z)); v1[2] = sigmoidf_(bflo(g.w)); v1[3] = sigmoidf_(bfhi(g.w));
                    *(u32x4*)p = pack8(v0 * acc[ai][bj][m][0], v1 * acc[ai][bj][m][1]); } }
    }
};
struct EpiMG {
    static constexpr bool PERM = true;
    bf16_t* proj;
    __device__ __forceinline__ void operator()(Acc& acc, const Unit& u, int wr, int wc, int fr, int fq) const {
#pragma unroll
        for (int ai = 0; ai < 2; ++ai)
#pragma unroll
            for (int m = 0; m < 4; ++m) { const int row = u.pm * 256 + ai * 128 + wr * 64 + m * 16 + fr;
#pragma unroll
                for (int bj = 0; bj < 2; ++bj) { const int col = u.pn * 256 + bj * 128 + wc * 32 + 8 * fq; bf16_t* p = proj + (size_t)row * NPROJ + PGA0 + col;
                    const u32x4 g = *(const u32x4*)p; const u32x4 y = *(const u32x4*)(proj + (size_t)row * NPROJ + PGB0 + col);
                    f32x4 v0, v1, y0, y1; v0[0] = sigmoidf_(bflo(g.x)); v0[1] = sigmoidf_(bfhi(g.x)); v0[2] = sigmoidf_(bflo(g.y)); v0[3] = sigmoidf_(bfhi(g.y));
                    v1[0] = sigmoidf_(bflo(g.z)); v1[1] = sigmoidf_(bfhi(g.z)); v1[2] = sigmoidf_(bflo(g.w)); v1[3] = sigmoidf_(bfhi(g.w));
                    y0[0] = bflo(y.x); y0[1] = bfhi(y.x); y0[2] = bflo(y.y); y0[3] = bfhi(y.y); y1[0] = bflo(y.z); y1[1] = bfhi(y.z); y1[2] = bflo(y.w); y1[3] = bfhi(y.w);
                    *(u32x4*)p = pack8(v0 * acc[ai][bj][m][0] + y0, v1 * acc[ai][bj][m][1] + y1); } }
    }
};
struct EpiSoftmax {
    static constexpr bool PERM = true;
    bf16_t* O; LAS float* scr; const float* ssq;
    __device__ __forceinline__ void operator()(Acc& acc, const Unit& u, int wr, int wc, int fr, int fq) const {
        LAS float* MX = scr; LAS float* SM = scr + 1024;
        float rr[2][4]; rows_rs(ssq, u.pm * 256 + wr * 64 + fr, fq, rr);
#pragma unroll
        for (int ai = 0; ai < 2; ++ai)
#pragma unroll
            for (int m = 0; m < 4; ++m) { float v = -3.0e38f; const float r = rr[ai][m];
#pragma unroll
                for (int bj = 0; bj < 2; ++bj)
#pragma unroll
                    for (int n = 0; n < 2; ++n)
#pragma unroll
                        for (int j = 0; j < 4; ++j) { acc[ai][bj][m][n][j] *= r; v = fmaxf(v, acc[ai][bj][m][n][j]); }
                v = fmaxf(v, __shfl_xor(v, 16)); v = fmaxf(v, __shfl_xor(v, 32));
                if (fq == 0) MX[(ai * 128 + wr * 64 + m * 16 + fr) * 4 + wc] = v; }
        LDS_WAIT(); __builtin_amdgcn_s_barrier(); asm volatile("" ::: "memory");
#pragma unroll
        for (int ai = 0; ai < 2; ++ai)
#pragma unroll
            for (int m = 0; m < 4; ++m) { const int rl = ai * 128 + wr * 64 + m * 16 + fr; const f32x4 q = *(const LAS f32x4*)(MX + rl * 4);
                const float mxr = fmaxf(fmaxf(q[0], q[1]), fmaxf(q[2], q[3])); float s = 0.f;
#pragma unroll
                for (int bj = 0; bj < 2; ++bj)
#pragma unroll
                    for (int n = 0; n < 2; ++n)
#pragma unroll
                        for (int j = 0; j < 4; ++j) { const float e = __expf(acc[ai][bj][m][n][j] - mxr); acc[ai][bj][m][n][j] = e; s += e; }
                s += __shfl_xor(s, 16); s += __shfl_xor(s, 32);
                if (fq == 0) SM[rl * 4 + wc] = s; }
        LDS_WAIT(); __builtin_amdgcn_s_barrier(); asm volatile("" ::: "memory");
#pragma unroll
        for (int ai = 0; ai < 2; ++ai)
#pragma unroll
            for (int m = 0; m < 4; ++m) { const int rl = ai * 128 + wr * 64 + m * 16 + fr; const f32x4 q = *(const LAS f32x4*)(SM + rl * 4);
                const float inv = __builtin_amdgcn_rcpf((q[0] + q[1]) + (q[2] + q[3])); const int row = u.pm * 256 + rl;
#pragma unroll
                for (int bj = 0; bj < 2; ++bj) *(u32x4*)(O + (size_t)row * 1024 + u.pn * 256 + bj * 128 + wc * 32 + 8 * fq) = pack8(acc[ai][bj][m][0] * inv, acc[ai][bj][m][1] * inv); }
    }
};

struct Args {
    const float* in[27]; float* out; unsigned char* ws; int ph_lo, ph_hi;
};
enum { I_X = 0, I_MEM, I_F1N, I_F1W1, I_F1W3, I_F1W2, I_MIXN, I_WIN, I_WAL, I_BAL, I_GHN, I_WUPA, I_PMIX, I_PSC, I_WUPB, I_WMIX, I_XAN, I_MEMN, I_XWQ, I_XWK, I_XWV, I_XWO,
       I_F2N, I_F2W1, I_F2W3, I_F2W2, I_FN };

__device__ __forceinline__ void cvt_item(const float* W, int ldw, int col0, int k0, const float* gain, float scale, bf16_t* dst, int ldd, int drow0, LAS float* scr, int lane) {
    float v[32], g[32];
    const float* wp = W + (size_t)(k0 + (lane >> 5)) * ldw + col0 + (lane & 31);
#pragma unroll
    for (int i = 0; i < 32; ++i) v[i] = wp[(size_t)(2 * i) * ldw];
    if (gain) {
#pragma unroll
        for (int i = 0; i < 32; ++i) g[i] = gain[k0 + 2 * i + (lane >> 5)];
    }
#pragma unroll
    for (int i = 0; i < 32; ++i) scr[(2 * i + (lane >> 5)) * 33 + (lane & 31)] = v[i] * (gain ? g[i] * scale : scale);
    LDS_WAIT(); asm volatile("" ::: "memory");
    const int c = lane & 7;
#pragma unroll
    for (int j = 0; j < 4; ++j) { const int n = (lane >> 3) + 8 * j; const LAS float* s = scr + (8 * c) * 33 + n;
        u32x4 o; o.x = pk2(s[0 * 33], s[1 * 33]); o.y = pk2(s[2 * 33], s[3 * 33]); o.z = pk2(s[4 * 33], s[5 * 33]); o.w = pk2(s[6 * 33], s[7 * 33]);
        *(u32x4*)(dst + (size_t)(drow0 + n) * ldd + k0 + 8 * c) = o; }
    LDS_WAIT(); asm volatile("" ::: "memory");
}
__device__ __forceinline__ void cvt_plain(const float* W, int K, int N, const float* gain, float scale, bf16_t* dst, int drow_off, LAS float* scr, int it, int lane) {
    const int nblk = N / 32, kb = it / nblk, nb = it % nblk;
    cvt_item(W, N, nb * 32, kb * 64, gain, scale, dst, K, drow_off + nb * 32, scr, lane);
}
__device__ __forceinline__ void cvt_w13(const float* W1, const float* W3, const float* gain, bf16_t* dst, LAS float* scr, int it, int lane) {
    const int nblk = 5632 / 32, kb = it / nblk, nb = it % nblk, pn = nb >> 3, cb = nb & 7;
    cvt_item(cb < 4 ? W1 : W3, FF, pn * 128 + (cb & 3) * 32, kb * 64, gain, 1.f, dst, 1024, nb * 32, scr, lane);
}
__device__ __forceinline__ void cvt_win(const float* W, const float* gain, bf16_t* dst, LAS float* scr, int it, int lane) {
    const int nblk = NPROJ / 32, kb = it / nblk, nb = it % nblk, n0 = nb * 32;
    cvt_item(W, WIN_LD, n0 + (n0 >= 3072 ? 16 : 0), kb * 64, gain, 1.f, dst, 1024, n0, scr, lane);
}
constexpr int PI13 = 176 * 16, PI2 = 32 * 44, PISQ = 32 * 16;
constexpr int PREP_EARLY = PI13 + 2 * PISQ, PREP_NITEMS = 2 * PI13 + PI2 + 6 * PISQ + 1024 + 16;
__device__ __forceinline__ void prep_items(const Args& a, LAS unsigned char* lds, int first, int last, int gw, int NGW) {
    const int tid = threadIdx.x, lane = tid & 63, wave = __builtin_amdgcn_readfirstlane(tid >> 6);
    LAS float* scr = (LAS float*)(lds + wave * 16384);
    unsigned char* ws = a.ws;
    constexpr int I13 = PI13, I2 = PI2, ISQ = PISQ;
    for (int it = first + gw; it < last; it += NGW) {
        int r = it;
        if (r < I13) { cvt_w13(a.in[I_F1W1], a.in[I_F1W3], a.in[I_F1N], (bf16_t*)(ws + W_1C1), scr, r, lane); continue; } r -= I13;
        if (r < ISQ) { cvt_plain(a.in[I_XWK], D, D, a.in[I_MEMN], 1.f, (bf16_t*)(ws + W_KV), 0, scr, r, lane); continue; } r -= ISQ;
        if (r < ISQ) { cvt_plain(a.in[I_XWV], D, D, a.in[I_MEMN], 1.f, (bf16_t*)(ws + W_KV), 1024, scr, r, lane); continue; } r -= ISQ;
        if (r < I2) { cvt_plain(a.in[I_F1W2], FF, D, nullptr, 1.f, (bf16_t*)(ws + W_21), 0, scr, r, lane); continue; } r -= I2;
        if (r < I13) { cvt_win(a.in[I_WIN], a.in[I_MIXN], (bf16_t*)(ws + W_IN), scr, r, lane); continue; } r -= I13;
        if (r < 16) {
            const int k = r * 64 + lane; const float g = a.in[I_MIXN][k]; const float* w = a.in[I_WIN] + (size_t)k * WIN_LD + 3072;
#pragma unroll
            for (int j = 0; j < 16; ++j) ((bf16_t*)(ws + W_AT))[j * 1024 + k] = (bf16_t)f2bf(w[j] * g);
            continue; } r -= 16;
        if (r < ISQ) { cvt_plain(a.in[I_WUPA], D, D, nullptr, 1.f, (bf16_t*)(ws + W_UPA), 0, scr, r, lane); continue; } r -= ISQ;
        if (r < ISQ) { cvt_plain(a.in[I_WMIX], D, D, nullptr, 1.f, (bf16_t*)(ws + W_MIX), 0, scr, r, lane); continue; } r -= ISQ;
        if (r < ISQ) {
            const int k = r * 2 + (lane >> 5); const float g = a.in[I_XAN][k] * 0.0625f; const float* w = a.in[I_XWQ] + (size_t)k * D + (lane & 31) * 32; bf16_t* o = (bf16_t*)(ws + W_Q) + (size_t)k * D + (lane & 31) * 32;
#pragma unroll
            for (int q = 0; q < 4; ++q) { const f32x4 v0 = *(const f32x4*)(w + q * 8), v1 = *(const f32x4*)(w + q * 8 + 4); *(u32x4*)(o + q * 8) = pack8(v0 * g, v1 * g); }
            continue; } r -= ISQ;
        if (r < ISQ) { cvt_plain(a.in[I_XWO], D, D, nullptr, 1.f, (bf16_t*)(ws + W_O), 0, scr, r, lane); continue; } r -= ISQ;
        {
            const int gi = r >> 8, co = (r >> 4) & 15, nb = r & 15, n = nb * 64 + lane;
            const float* pm = a.in[I_PMIX] + (size_t)(gi * 128 + co * 8) * 128;
#pragma unroll
            for (int i = 0; i < 16; ++i) scr[i * 64 + lane] = pm[i * 64 + lane];
            LDS_WAIT(); asm volatile("" ::: "memory");
            float acc[8] = {0.f, 0.f, 0.f, 0.f, 0.f, 0.f, 0.f, 0.f};
            const float* wb = a.in[I_WUPB] + (size_t)(gi * 128) * 1024 + n; const float* sc = a.in[I_PSC] + gi * 128;
#pragma unroll 8
            for (int d = 0; d < 128; ++d) { const float wv = wb[(size_t)d * 1024] * sc[d];
#pragma unroll
                for (int cc = 0; cc < 8; ++cc) acc[cc] += scr[cc * 128 + d] * wv; }
            u32x4 o; o.x = pk2(acc[0], acc[1]); o.y = pk2(acc[2], acc[3]); o.z = pk2(acc[4], acc[5]); o.w = pk2(acc[6], acc[7]);
            *(u32x4*)((bf16_t*)(ws + W_PB) + (size_t)n * 512 + gi * 128 + co * 8) = o;
            LDS_WAIT(); asm volatile("" ::: "memory");
        }
    }
}
__device__ __forceinline__ void prep_late(const Args& a, LAS unsigned char* lds) {
    const int tid = threadIdx.x, lane = tid & 63, wave = __builtin_amdgcn_readfirstlane(tid >> 6);
    LAS float* scr = (LAS float*)(lds + wave * 16384);
    for (int it = blockIdx.x * 8 + wave; it < PI13 + PI2; it += gridDim.x * 8) {
        if (it < PI13) cvt_w13(a.in[I_F2W1], a.in[I_F2W3], a.in[I_F2N], (bf16_t*)(a.ws + W_1C2), scr, it, lane);
        else cvt_plain(a.in[I_F2W2], FF, D, nullptr, 1.f, (bf16_t*)(a.ws + W_22), 0, scr, it - PI13, lane);
    }
}
__device__ __forceinline__ void phase_prep_rows(const Args& a) {
    const int tid = threadIdx.x, lane = tid & 63, wave = __builtin_amdgcn_readfirstlane(tid >> 6);
    const int gw = blockIdx.x * 8 + wave, NGW = gridDim.x * 8;
    unsigned char* ws = a.ws;
    for (int m0 = gw; m0 < T + NBATCH * MEMLEN; m0 += 2 * NGW) {
        f32x4 v[2][4]; float s[2];
#pragma unroll
        for (int q = 0; q < 2; ++q) { const int m = m0 + q * NGW; const bool ok = m < T + NBATCH * MEMLEN; const bool isx = m < T; const int r = isx ? m : m - T;
            const f32x4* xr = (const f32x4*)((isx ? a.in[I_X] : a.in[I_MEM]) + (size_t)(ok ? r : 0) * D) + lane;
#pragma unroll
            for (int j = 0; j < 4; ++j) v[q][j] = xr[64 * j]; }
#pragma unroll
        for (int q = 0; q < 2; ++q) { const int m = m0 + q * NGW; if (m >= T + NBATCH * MEMLEN) continue; const bool isx = m < T; const int r = isx ? m : m - T;
            float ss = 0.f;
#pragma unroll
            for (int j = 0; j < 4; ++j) ss += (v[q][j][0] * v[q][j][0] + v[q][j][1] * v[q][j][1]) + (v[q][j][2] * v[q][j][2] + v[q][j][3] * v[q][j][3]);
            ss = wave_sum(ss); s[q] = ss;
            float sc = 1.f;
            if (isx) { if (lane < 16) ((float*)(ws + WS_SSQ))[(size_t)r * 16 + lane] = lane == 0 ? ss : 0.f; }
            else sc = __builtin_amdgcn_rsqf(ss * (1.0f / D) + EPS);
            u32x2* o8 = (u32x2*)((bf16_t*)(ws + (isx ? WS_XB : WS_MB)) + (size_t)r * D) + lane;
#pragma unroll
            for (int j = 0; j < 4; ++j) { u32x2 w; w.x = pk2(v[q][j][0] * sc, v[q][j][1] * sc); w.y = pk2(v[q][j][2] * sc, v[q][j][3] * sc); o8[64 * j] = w; } }
        (void)s;
    }
}

__device__ __forceinline__ void phase_acode(const Args& a) {
    const int tid = threadIdx.x, lane = tid & 63, wave = tid >> 6, fr = lane & 15, fq = lane >> 4;
    const bf16_t* XB = (const bf16_t*)(a.ws + WS_XB); const bf16_t* WAT = (const bf16_t*)(a.ws + W_AT); const float* ssq = (const float*)(a.ws + WS_SSQ); float* AC = (float*)(a.ws + WS_ACODE);
    for (int rg = blockIdx.x * 8 + wave; rg < T / 16; rg += gridDim.x * 8) {
        const bf16_t* ap = XB + (size_t)(rg * 16 + fr) * D + fq * 8; const bf16_t* bp = WAT + (size_t)fr * D + fq * 8;
        f32x4 c = {0.f, 0.f, 0.f, 0.f};
#pragma unroll 8
        for (int kk = 0; kk < 32; ++kk) { const bf16x8 xa = *(const bf16x8*)(ap + kk * 32); const bf16x8 wb = *(const bf16x8*)(bp + kk * 32);
            c = __builtin_amdgcn_mfma_f32_16x16x32_bf16(wb, xa, c, 0, 0, 0); }
        const float r = row_rs4(ssq, rg * 16 + fr, fq);
        *(f32x4*)(AC + (size_t)(rg * 16 + fr) * 16 + 4 * fq) = c * r;
    }
}

__device__ __forceinline__ void ld8(const bf16_t* p, float* f) { const u32x4 w = *(const u32x4*)p; f[0] = bflo(w.x); f[1] = bfhi(w.x); f[2] = bflo(w.y); f[3] = bfhi(w.y); f[4] = bflo(w.z); f[5] = bfhi(w.z); f[6] = bflo(w.w); f[7] = bfhi(w.w); }
__device__ __forceinline__ void phase_pool(const Args& a) {
    const int tid = threadIdx.x, co = tid & 63, tsub = tid >> 6, gi = co >> 4, w = 2 << gi;
    const bf16_t* __restrict__ U = (const bf16_t*)(a.ws + WS_PROJ) + PU0 + co * 8; bf16_t* __restrict__ P = (bf16_t*)a.out + co * 8;
    for (int tile = blockIdx.x; tile < T / 64; tile += gridDim.x) {
        const int t0 = tile * 64 + tsub * 8, p0 = t0 & (SEQ - 1);
        float acc[8] = {0.f, 0.f, 0.f, 0.f, 0.f, 0.f, 0.f, 0.f}, f[8];
        for (int d = 1; d < w; ++d) if (p0 - d >= 0) { ld8(U + (size_t)(t0 - d) * NPROJ, f);
#pragma unroll
            for (int c = 0; c < 8; ++c) acc[c] += f[c]; }
        for (int k = 0; k < 8; ++k) {
            const int t = t0 + k, p = p0 + k; ld8(U + (size_t)t * NPROJ, f);
            const float inv = 1.0f / (float)(p + 1 < w ? p + 1 : w);
            float o[8];
#pragma unroll
            for (int c = 0; c < 8; ++c) { acc[c] += f[c]; o[c] = acc[c] * inv - f[c]; }
            u32x4 ow; ow.x = pk2(o[0], o[1]); ow.y = pk2(o[2], o[3]); ow.z = pk2(o[4], o[5]); ow.w = pk2(o[6], o[7]);
            *(u32x4*)(P + (size_t)t * 512) = ow;
            if (p - w + 1 >= 0) { float g[8]; ld8(U + (size_t)(t - w + 1) * NPROJ, g);
#pragma unroll
                for (int c = 0; c < 8; ++c) acc[c] -= g[c]; }
        }
    }
}

constexpr int GL_QT = 0, GL_KT = 17408, GL_KD = 34816, GL_VT = 53248, GL_PM = 90112, GL_TOT = 99328, GL_DL = 101376, GL_RS = 101888, GL_AC = 103936;
template <int MODE> __device__ __forceinline__ void gla_units(const Args& a, LAS unsigned char* lds) {
    const int tid = threadIdx.x, lane = tid & 63, wave = __builtin_amdgcn_readfirstlane(tid >> 6), fr = lane & 15, fq = lane >> 4;
    LAS bf16_t* QT = (LAS bf16_t*)(lds + GL_QT); LAS bf16_t* KT = (LAS bf16_t*)(lds + GL_KT); LAS bf16_t* KD = (LAS bf16_t*)(lds + GL_KD);
    LAS bf16_t* VT = (LAS bf16_t*)(lds + GL_VT); LAS bf16_t* PM = (LAS bf16_t*)(lds + GL_PM);
    LAS float* TOT = (LAS float*)(lds + GL_TOT); LAS float* DL = (LAS float*)(lds + GL_DL); LAS float* RS = (LAS float*)(lds + GL_RS); LAS float* ACL = (LAS float*)(lds + GL_AC);
    bf16_t* PROJ = (bf16_t*)(a.ws + WS_PROJ); const float* AC = (const float*)(a.ws + WS_ACODE);
    bf16_t* STG = (bf16_t*)((char*)a.out + 32 * MiB); float* LDG = (float*)(a.ws + WS_LDG);
    const int dk = tid & 127, pg = wave >> 1;
    const int dv = tid & 255, ph = wave >> 2;
    for (int unit = blockIdx.x; unit < 256; unit += gridDim.x) {
        const int bh = unit >> 3, g = unit & 7, b = bh >> 2, h = bh & 3;
        const size_t row0 = (size_t)b * SEQ + g * 512;
        float wal[16];
#pragma unroll
        for (int j = 0; j < 16; ++j) wal[j] = a.in[I_WAL][j * 512 + h * 128 + dk];
        const float bal = a.in[I_BAL][h * 128 + dk];
        f32x4 st[8][2];
        if (MODE == 1) {
            const u32x2* sp = (const u32x2*)(STG + (size_t)unit * 32768) + (wave * 16) * 64 + lane;
#pragma unroll
            for (int tk = 0; tk < 8; ++tk)
#pragma unroll
                for (int tv = 0; tv < 2; ++tv) { const u32x2 w = sp[(tk * 2 + tv) * 64]; st[tk][tv] = (f32x4){bflo(w.x), bfhi(w.x), bflo(w.y), bfhi(w.y)}; }
        } else {
#pragma unroll
            for (int tk = 0; tk < 8; ++tk)
#pragma unroll
                for (int tv = 0; tv < 2; ++tv) st[tk][tv] = (f32x4){0.f, 0.f, 0.f, 0.f};
        }
        float lsum = 0.f;
        {
            const f32x4* src = (const f32x4*)(AC + row0 * 16); LAS f32x4* dst = (LAS f32x4*)ACL;
            dst[tid] = src[tid]; dst[tid + 512] = src[tid + 512]; dst[tid + 1024] = src[tid + 1024]; dst[tid + 1536] = src[tid + 1536];
        }
        for (int c = 0; c < 8; ++c) {
            const size_t rowc = row0 + c * 64;
            unsigned short vraw[32];
            { const bf16_t* vp = PROJ + (rowc + ph * 32) * NPROJ + PV0 + h * 256 + dv;
#pragma unroll
              for (int i = 0; i < 32; ++i) vraw[i] = vp[(size_t)i * NPROJ]; }
            float bl[16]; float run = 0.f;
            if (c == 0) { LDS_WAIT(); __builtin_amdgcn_s_barrier(); asm volatile("" ::: "memory"); }
            { const LAS f32x4* acp = (const LAS f32x4*)(ACL + (c * 64 + pg * 16) * 16);
#pragma unroll
              for (int i = 0; i < 16; ++i) { const f32x4 c0 = acp[i * 4 + 0], c1 = acp[i * 4 + 1], c2 = acp[i * 4 + 2], c3 = acp[i * 4 + 3];
                  float z = bal;
                  z += c0[0] * wal[0] + c0[1] * wal[1] + c0[2] * wal[2] + c0[3] * wal[3]; z += c1[0] * wal[4] + c1[1] * wal[5] + c1[2] * wal[6] + c1[3] * wal[7];
                  z += c2[0] * wal[8] + c2[1] * wal[9] + c2[2] * wal[10] + c2[3] * wal[11]; z += c3[0] * wal[12] + c3[1] * wal[13] + c3[2] * wal[14] + c3[3] * wal[15];
                  const float ls = fminf(z, 0.f) - __logf(1.f + __expf(-fabsf(z)));
                  run += ls * 0.0625f; bl[i] = run; } }
            unsigned short qraw[16], kraw[16];
            { const bf16_t* qp = PROJ + (rowc + pg * 16) * NPROJ + PQ0 + h * 128 + dk;
#pragma unroll
              for (int i = 0; i < 16; ++i) { qraw[i] = qp[(size_t)i * NPROJ]; kraw[i] = qp[(size_t)i * NPROJ + (PK0 - PQ0)]; } }
            TOT[pg * 128 + dk] = run;
            LDS_WAIT(); __builtin_amdgcn_s_barrier(); asm volatile("" ::: "memory");
            const float t0 = TOT[dk], t1 = TOT[128 + dk], t2 = TOT[256 + dk], t3 = TOT[384 + dk];
            const float offs = pg == 0 ? 0.f : pg == 1 ? t0 : pg == 2 ? t0 + t1 : (t0 + t1) + t2;
            const float blast = ((t0 + t1) + t2) + t3;
            lsum += blast;
            { unsigned kd[8];
#pragma unroll
              for (int i = 0; i < 16; ++i) { const float bc = offs + bl[i]; const float eq = __expf(bc), ek = __builtin_amdgcn_rcpf(eq);
                  const int pos = pg * 16 + i;
                  if (MODE == 1) QT[pos * 136 + dk] = (bf16_t)f2bf(bf2f(qraw[i]) * 0.08838834764831845f * eq);
                  const unsigned kt = f2bf(bf2f(kraw[i]) * ek);
                  if (MODE == 1) KT[pos * 136 + dk] = (bf16_t)kt;
                  if (i & 1) kd[i >> 1] |= kt << 16; else kd[i >> 1] = kt; }
              *(LAS u32x4*)(KD + dk * 72 + pg * 16) = (u32x4){kd[0], kd[1], kd[2], kd[3]};
              *(LAS u32x4*)(KD + dk * 72 + pg * 16 + 8) = (u32x4){kd[4], kd[5], kd[6], kd[7]}; }
            if (pg == 0) DL[dk] = __expf(blast);
            {
#pragma unroll
              for (int q = 0; q < 4; ++q) { u32x4 w; w.x = vraw[q * 8 + 0] | ((unsigned)vraw[q * 8 + 1] << 16); w.y = vraw[q * 8 + 2] | ((unsigned)vraw[q * 8 + 3] << 16);
                  w.z = vraw[q * 8 + 4] | ((unsigned)vraw[q * 8 + 5] << 16); w.w = vraw[q * 8 + 6] | ((unsigned)vraw[q * 8 + 7] << 16);
                  *(LAS u32x4*)(VT + dv * 72 + ph * 32 + q * 8) = w; } }
            LDS_WAIT(); __builtin_amdgcn_s_barrier(); asm volatile("" ::: "memory");
            if (MODE == 1) {
                { const int ti = wave >> 1;
#pragma unroll
                  for (int jj = 0; jj < 2; ++jj) { const int tj = (wave & 1) * 2 + jj; f32x4 s = {0.f, 0.f, 0.f, 0.f};
                      if (tj <= ti) {
#pragma unroll
                          for (int kk = 0; kk < 4; ++kk) { const bf16x8 kf = *(const LAS bf16x8*)(KT + (tj * 16 + fr) * 136 + kk * 32 + fq * 8); const bf16x8 qf = *(const LAS bf16x8*)(QT + (ti * 16 + fr) * 136 + kk * 32 + fq * 8);
                              s = __builtin_amdgcn_mfma_f32_16x16x32_bf16(kf, qf, s, 0, 0, 0); } }
                      const int i = ti * 16 + fr, j0 = tj * 16 + fq * 4;
                      u32x2 w; w.x = pk2m(j0 + 0 <= i ? s[0] : 0.f, j0 + 1 <= i ? s[1] : 0.f); w.y = pk2m(j0 + 2 <= i ? s[2] : 0.f, j0 + 3 <= i ? s[3] : 0.f);
                      *(LAS u32x2*)(PM + i * 72 + j0) = w; } }
                LDS_WAIT(); __builtin_amdgcn_s_barrier(); asm volatile("" ::: "memory");
                f32x4 oa[2][4];
#pragma unroll
                for (int tv = 0; tv < 2; ++tv)
#pragma unroll
                    for (int ti = 0; ti < 4; ++ti) { f32x4 o = {0.f, 0.f, 0.f, 0.f};
#pragma unroll
                        for (int kk = 0; kk < 2; ++kk) { if (kk * 32 > ti * 16 + 15) continue;
                            const bf16x8 vf = *(const LAS bf16x8*)(VT + (wave * 32 + tv * 16 + fr) * 72 + kk * 32 + fq * 8); const bf16x8 pf = *(const LAS bf16x8*)(PM + (ti * 16 + fr) * 72 + kk * 32 + fq * 8);
                            o = __builtin_amdgcn_mfma_f32_16x16x32_bf16(vf, pf, o, 0, 0, 0); }
#pragma unroll
                        for (int tp = 0; tp < 4; ++tp) {
                            const f32x4 s0 = st[2 * tp][tv], s1 = st[2 * tp + 1][tv]; u32x4 sw; sw.x = pk2m(s0[0], s0[1]); sw.y = pk2m(s0[2], s0[3]); sw.z = pk2m(s1[0], s1[1]); sw.w = pk2m(s1[2], s1[3]);
                            const u32x2 q0 = *(const LAS u32x2*)(QT + (ti * 16 + fr) * 136 + tp * 32 + fq * 4), q1 = *(const LAS u32x2*)(QT + (ti * 16 + fr) * 136 + tp * 32 + 16 + fq * 4);
                            const u32x4 qw = {q0.x, q0.y, q1.x, q1.y};
                            o = __builtin_amdgcn_mfma_f32_16x16x32_bf16(__builtin_bit_cast(bf16x8, sw), __builtin_bit_cast(bf16x8, qw), o, 0, 0, 0); }
                        oa[tv][ti] = o; }
                u32x2 rwv[4][2]; f32x4 gnv[2];
#pragma unroll
                for (int tv = 0; tv < 2; ++tv) gnv[tv] = *(const f32x4*)(a.in[I_GHN] + wave * 32 + tv * 16 + fq * 4);
#pragma unroll
                for (int ti = 0; ti < 4; ++ti)
#pragma unroll
                    for (int tv = 0; tv < 2; ++tv) rwv[ti][tv] = *(const u32x2*)(PROJ + (rowc + ti * 16 + fr) * NPROJ + PR0 + h * 256 + wave * 32 + tv * 16 + fq * 4);
#pragma unroll
                for (int ti = 0; ti < 4; ++ti) { float ss = 0.f;
#pragma unroll
                    for (int tv = 0; tv < 2; ++tv) { const f32x4 o = oa[tv][ti]; ss += (o[0] * o[0] + o[1] * o[1]) + (o[2] * o[2] + o[3] * o[3]); }
                    ss += __shfl_xor(ss, 16); ss += __shfl_xor(ss, 32);
                    if (fq == 0) RS[wave * 64 + ti * 16 + fr] = ss; }
                LDS_WAIT(); __builtin_amdgcn_s_barrier(); asm volatile("" ::: "memory");
#pragma unroll
                for (int ti = 0; ti < 4; ++ti) { const int i = ti * 16 + fr; float ss = 0.f;
#pragma unroll
                    for (int w8 = 0; w8 < 8; ++w8) ss += RS[w8 * 64 + i];
                    const float rn = __builtin_amdgcn_rsqf(ss * (1.0f / 256.0f) + EPS);
#pragma unroll
                    for (int tv = 0; tv < 2; ++tv) { const int v0 = wave * 32 + tv * 16 + fq * 4;
                        const f32x4 gn = gnv[tv];
                        bf16_t* pr = PROJ + (rowc + i) * NPROJ + h * 256 + v0; const u32x2 rw = rwv[ti][tv];
                        const f32x4 o = oa[tv][ti]; u32x2 w;
                        w.x = pk2m(o[0] * rn * gn[0] * siluf_(bflo(rw.x)), o[1] * rn * gn[1] * siluf_(bfhi(rw.x)));
                        w.y = pk2m(o[2] * rn * gn[2] * siluf_(bflo(rw.y)), o[3] * rn * gn[3] * siluf_(bfhi(rw.y)));
                        *(u32x2*)(pr + PV0) = w; } }
            }
            if (MODE == 0 || c < 7) {
#pragma unroll
                for (int tk = 0; tk < 8; ++tk) { const f32x4 dd = *(const LAS f32x4*)(DL + tk * 16 + fq * 4);
#pragma unroll
                    for (int tv = 0; tv < 2; ++tv) { f32x4 s = st[tk][tv];
#pragma unroll
                        for (int kk = 0; kk < 2; ++kk) { const bf16x8 kf = *(const LAS bf16x8*)(KD + (tk * 16 + fr) * 72 + kk * 32 + fq * 8); const bf16x8 vf = *(const LAS bf16x8*)(VT + (wave * 32 + tv * 16 + fr) * 72 + kk * 32 + fq * 8);
                            s = __builtin_amdgcn_mfma_f32_16x16x32_bf16(kf, vf, s, 0, 0, 0); }
                        st[tk][tv] = s * dd; } }
            }
        }
        if (MODE == 0) {
            u32x2* sp = (u32x2*)(STG + (size_t)unit * 32768) + (wave * 16) * 64 + lane;
#pragma unroll
            for (int tk = 0; tk < 8; ++tk)
#pragma unroll
                for (int tv = 0; tv < 2; ++tv) { const f32x4 s = st[tk][tv]; u32x2 w; w.x = pk2m(s[0], s[1]); w.y = pk2m(s[2], s[3]); sp[(tk * 2 + tv) * 64] = w; }
            if (pg == 0) LDG[unit * 128 + dk] = lsum;
        }
    }
    LDS_WAIT(); __syncthreads();
}
__device__ __forceinline__ void phase_gla_scan(const Args& a) {
    bf16_t* STG = (bf16_t*)((char*)a.out + 32 * MiB); const float* LDG = (const float*)(a.ws + WS_LDG);
    for (int e = blockIdx.x * 512 + threadIdx.x; e < 32 * 8192; e += gridDim.x * 512) {
        const int bh = e >> 13, slot = e & 8191, lane = slot & 63, tl = (slot >> 6) & 15, k0 = (tl >> 1) * 16 + (lane >> 4) * 4;
        u32x2* p = (u32x2*)(STG + (size_t)bh * 8 * 32768) + slot;
        u32x2 uu[8];
#pragma unroll
        for (int g = 0; g < 8; ++g) uu[g] = p[(size_t)g * 8192];
        f32x4 s = {0.f, 0.f, 0.f, 0.f};
#pragma unroll
        for (int g = 0; g < 8; ++g) {
            u32x2 w; w.x = pk2(s[0], s[1]); w.y = pk2(s[2], s[3]); p[(size_t)g * 8192] = w;
            const f32x4 ld = *(const f32x4*)(LDG + (bh * 8 + g) * 128 + k0);
            s[0] = __expf(ld[0]) * s[0] + bflo(uu[g].x); s[1] = __expf(ld[1]) * s[1] + bfhi(uu[g].x);
            s[2] = __expf(ld[2]) * s[2] + bflo(uu[g].y); s[3] = __expf(ld[3]) * s[3] + bfhi(uu[g].y);
        }
    }
}
__device__ __forceinline__ void phase_final(const Args& a) {
    const int lane = threadIdx.x & 63, wave = threadIdx.x >> 6; const float* __restrict__ ssq = (const float*)(a.ws + WS_SSQ); const bf16_t* __restrict__ XB = (const bf16_t*)(a.ws + WS_XB);
    float* __restrict__ out = a.out; const f32x4* gp = (const f32x4*)a.in[I_FN] + 2 * lane;
    const f32x4 g00 = gp[0], g01 = gp[1], g10 = gp[128], g11 = gp[129];
    const int NW = gridDim.x * 8;
    for (int m0 = blockIdx.x * 8 + wave; m0 < T; m0 += 4 * NW) {
        u32x4 b[4][2]; float r[4];
#pragma unroll
        for (int q = 0; q < 4; ++q) { const int m = m0 + q * NW < T ? m0 + q * NW : m0; const u32x4* xr = (const u32x4*)(XB + (size_t)m * D) + lane; b[q][0] = xr[0]; b[q][1] = xr[64]; r[q] = row_rs(ssq, m); }
#pragma unroll
        for (int q = 0; q < 4; ++q) { const int m = m0 + q * NW; if (m >= T) continue; f32x4* orow = (f32x4*)(out + (size_t)m * D) + 2 * lane;
#pragma unroll
            for (int j = 0; j < 2; ++j) { const u32x4 w = b[q][j]; f32x4 o0, o1; o0[0] = bflo(w.x); o0[1] = bfhi(w.x); o0[2] = bflo(w.y); o0[3] = bfhi(w.y); o1[0] = bflo(w.z); o1[1] = bfhi(w.z); o1[2] = bflo(w.w); o1[3] = bfhi(w.w);
                orow[128 * j] = o0 * r[q] * (j ? g10 : g00); orow[128 * j + 1] = o1 * r[q] * (j ? g11 : g01); } }
    }
}

#define XB_TMO      128
#define XB_XCNT(j)  (256  + 64 * (j))
#define XB_XSUB(j)  (1280 + 64 * (j))
#define XB_XGEN(j)  (2304 + 64 * (j))
#define XB_TOP      3328
#define XB_TOPGEN   3392
#define XCD_BAR_WORDS 3456
#define XB_SPIN_CAP (1u << 22)
__device__ __forceinline__ unsigned xb_ld(unsigned* p)              { return __hip_atomic_load(p, __ATOMIC_RELAXED, __HIP_MEMORY_SCOPE_AGENT); }
__device__ __forceinline__ unsigned xb_add(unsigned* p, unsigned v) { return __hip_atomic_fetch_add(p, v, __ATOMIC_RELAXED, __HIP_MEMORY_SCOPE_AGENT); }
__device__ __forceinline__ unsigned xb_xcc_id() { return (unsigned)__builtin_amdgcn_s_getreg((3 << 11) | 20) & 0xFu; }
#define XB_SPIN(cond, bar) do { unsigned _sp = 0; while (cond) { __builtin_amdgcn_s_sleep(1); \
    if ((++_sp & 255u) == 0u) { if (xb_ld(&(bar)[XB_TMO])) break; if (_sp > XB_SPIN_CAP) { atomicAdd(&(bar)[XB_TMO], 1u); break; } } } } while (0)
struct XcdBarrier { unsigned* bar; unsigned x; volatile LAS unsigned* st; };
__device__ __forceinline__ XcdBarrier xcd_barrier_post(unsigned* bar, volatile LAS unsigned* st) {
    XcdBarrier b; b.bar = bar; b.x = xb_xcc_id(); b.st = st;
    if (threadIdx.x == 0) (void)xb_add(&bar[XB_XCNT(b.x)], 1u);
    return b;
}
__device__ __forceinline__ void xcd_barrier_complete(unsigned* bar, unsigned x, unsigned& nloc, unsigned& nx);
__device__ __forceinline__ void xcd_barrier_census(const XcdBarrier& b) {
    if (threadIdx.x == 0) { unsigned nloc, nx; xcd_barrier_complete(b.bar, b.x, nloc, nx); b.st[0] = nloc; b.st[1] = nx; }
    __syncthreads();
}
__device__ __forceinline__ void xcd_barrier_complete(unsigned* bar, unsigned x, unsigned& nloc, unsigned& nx) {
    const unsigned G = gridDim.x * gridDim.y * gridDim.z;
    unsigned sum, cnt, mine, sp = 0u;
    for (;;) {
        sum = 0u; cnt = 0u; mine = 0u;
#pragma unroll
        for (unsigned j = 0; j < 16; ++j) { const unsigned c = xb_ld(&bar[XB_XCNT(j)]); sum += c; cnt += (c > 0u) ? 1u : 0u; mine = (j == x) ? c : mine; }
        if (sum == G) break;
        __builtin_amdgcn_s_sleep(1);
        if ((++sp & 255u) == 0u) { if (xb_ld(&bar[XB_TMO])) break; if (sp > XB_SPIN_CAP) { atomicAdd(&bar[XB_TMO], 1u); break; } }
    }
    nloc = mine > 0u ? mine : 1u; nx = cnt > 0u ? cnt : 1u;
}
__device__ __forceinline__ void xcd_barrier(const XcdBarrier& b) {
    asm volatile("s_waitcnt vmcnt(0)" ::: "memory");
    __syncthreads();
    if (threadIdx.x == 0) {
        unsigned* bar = b.bar;
        __builtin_amdgcn_s_waitcnt(0);
        const unsigned nloc = b.st[0], nx = b.st[1];
        const unsigned old = xb_add(&bar[XB_XSUB(b.x)], 1u);
        const unsigned gen = old / nloc;
        if (old + 1u == (gen + 1u) * nloc) {
            __builtin_amdgcn_fence(__ATOMIC_RELEASE, "agent");
            asm volatile("s_waitcnt vmcnt(0)" ::: "memory");
            const unsigned og = xb_add(&bar[XB_TOP], 1u);
            const unsigned tg = og / nx;
            if (og + 1u == (tg + 1u) * nx) xb_add(&bar[XB_TOPGEN], 1u);
            else XB_SPIN(xb_ld(&bar[XB_TOPGEN]) == tg, bar);
            __builtin_amdgcn_fence(__ATOMIC_ACQUIRE, "agent");
            xb_add(&bar[XB_XGEN(b.x)], 1u);
            asm volatile("s_waitcnt vmcnt(0)" ::: "memory");
        } else {
            XB_SPIN(xb_ld(&bar[XB_XGEN(b.x)]) == gen, bar);
            __builtin_amdgcn_fence(__ATOMIC_ACQUIRE, "agent");
            asm volatile("s_waitcnt vmcnt(0)" ::: "memory");
        }
    }
    __syncthreads();
}

__global__ void __launch_bounds__(512, 2) hybrid_fwd(Args args) {
    extern __shared__ __attribute__((aligned(16))) unsigned char lds_raw[];
    LAS unsigned char* lds = (LAS unsigned char*)lds_raw;
    cg::grid_group grid = cg::this_grid();
    unsigned char* ws = args.ws;
    const int lo = args.ph_lo, hi = args.ph_hi, G = gridDim.x, c = blockIdx.x;
    const char* XB = (const char*)(ws + WS_XB); bf16_t* PROJ = (bf16_t*)(ws + WS_PROJ); float* SSQ = (float*)(ws + WS_SSQ);
#ifndef PH_MASK
#define PH_MASK 0xffff
#endif
#define IN(k) (((PH_MASK >> (k)) & 1) && lo <= (k) && (k) < hi)
    volatile LAS unsigned* bst = (volatile LAS unsigned*)(lds + EPI_LDS_OFF + 8192);
    if (threadIdx.x < 2) bst[threadIdx.x] = 0u;
    __syncthreads();
    XcdBarrier xbar; xbar.bar = (unsigned*)(ws + WS_CTL); xbar.x = 0; xbar.st = bst;
    if (hi - lo > 1) {
        if (c == 0) { unsigned* ctl = (unsigned*)(ws + WS_CTL);
            for (int i = threadIdx.x; i < (int)(CTL_BYTES / 4); i += 512) __hip_atomic_store(&ctl[i], 0u, __ATOMIC_RELAXED, __HIP_MEMORY_SCOPE_AGENT);
            __threadfence(); }
        grid.sync();
        xbar = xcd_barrier_post((unsigned*)(ws + WS_CTL), bst); xcd_barrier_census(xbar); }
#define SEAM(k) do { if (IN(k) && IN((k) + 1)) { xcd_barrier(xbar); } } while (0)
    const int GC = G >= 64 ? G - 16 : G;
    {
        int npass = 2; asm volatile("" : "+s"(npass));
#pragma nounroll
        for (int pass = 0; pass < npass; ++pass) {
            const bool run = pass == 0 ? IN(0) : (IN(1) && (c >= GC || GC == G));
            if (run) { const int wv = threadIdx.x >> 6;
                prep_items(args, lds, pass ? PREP_EARLY : 0, pass ? PREP_NITEMS : PREP_EARLY, pass && GC != G ? (c - GC) * 8 + wv : c * 8 + wv, pass && GC != G ? (G - GC) * 8 : G * 8); __syncthreads(); }
            if (pass == 0) { if (IN(0)) phase_prep_rows(args); SEAM(0); }
        }
    }
    if (IN(1)) {
        SchedUpKV S; S.o.init(T / 256, 5632 / 256, GC, c); S.ws = (const char*)ws; S.offA = WS_XB; S.offB = W_1C1;
        EpiSwiGLU E{(bf16_t*)(ws + WS_H), SSQ, (bf16_t*)(ws + WS_KV)};
        if (c < GC || GC == G) pg8::gemm_phase(lds, 1024, 1024, 1024, S, E);
    } SEAM(1);
    if (IN(2)) {
        SchedPlain S; S.o.init(T / 256, 4, G, c); S.A = (const char*)(ws + WS_H); S.B = (const char*)(ws + W_21); S.ta = (size_t)256 * FF * 2; S.tb = (size_t)256 * FF * 2;
        EpiResid E{(bf16_t*)(ws + WS_XB), SSQ, 0.5f};
        pg8::gemm_phase(lds, FF, FF, FF, S, E);
    } SEAM(2);
    if (IN(3)) {
        SchedPlain S; S.o.init(T / 256, NPROJ / 256, G, c); S.A = XB; S.B = (const char*)(ws + W_IN); S.ta = (size_t)256 * 1024 * 2; S.tb = (size_t)256 * 1024 * 2;
        EpiScaleBf16<true> E{PROJ, NPROJ, SSQ};
        pg8::gemm_phase(lds, 1024, 1024, 1024, S, E);
        phase_acode(args);
    } SEAM(3);
    if (IN(4)) { gla_units<0>(args, lds); phase_pool(args); prep_late(args, lds); } SEAM(4);
    if (IN(5)) {
        phase_gla_scan(args);
        SchedPlain S; S.o.init(T / 256, 4, G, c); S.A = (const char*)args.out; S.B = (const char*)(ws + W_PB); S.ta = (size_t)256 * 512 * 2; S.tb = (size_t)256 * 512 * 2;
        EpiYB E{PROJ};
        pg8::gemm_phase(lds, 512, 512, 512, S, E);
        {
            SchedPre P; P.G = G; P.c = c; P.mode = 0; P.KV = (const char*)(ws + WS_KV); P.W = (const char*)(ws + W_Q);
            EpiPre EP{(bf16_t*)(ws + WS_WQK), 0};
            pg8::gemm_phase(lds, 256, 2048, 1024, P, EP);
        }
        {
            SchedPre P; P.G = G; P.c = (c + G / 2) % G; P.mode = 1; P.KV = (const char*)(ws + WS_KV); P.W = (const char*)(ws + W_O);
            EpiPre EP{(bf16_t*)(ws + WS_VWOT), 1};
            pg8::gemm_phase(lds, 256, 1024, 2048, P, EP);
        }
    } SEAM(5);
    if (IN(6)) { gla_units<1>(args, lds); } SEAM(6);
    if (IN(7)) {
        SchedPlain S; S.o.init(T / 256, 4, G, c); S.A = (const char*)(PROJ + PV0); S.B = (const char*)(ws + W_UPA); S.ta = (size_t)256 * NPROJ * 2; S.tb = (size_t)256 * 1024 * 2;
        EpiMG E{PROJ};
        pg8::gemm_phase(lds, 1024, NPROJ, 1024, S, E);
    } SEAM(7);
    if (IN(8)) {
        SchedPlain S; S.o.init(T / 256, 4, G, c); S.A = (const char*)(PROJ + PGA0); S.B = (const char*)(ws + W_MIX); S.ta = (size_t)256 * NPROJ * 2; S.tb = (size_t)256 * 1024 * 2;
        EpiResid E{(bf16_t*)(ws + WS_XB), SSQ, 1.0f};
        pg8::gemm_phase(lds, 1024, NPROJ, 1024, S, E);
    } SEAM(8);
    if (IN(9)) {
        SchedAttn S; S.G = G; S.c = c; S.A = XB; S.B = (const char*)(ws + WS_WQK);
        EpiSoftmax E{(bf16_t*)(ws + WS_PR), (LAS float*)(lds + EPI_LDS_OFF), SSQ};
        pg8::gemm_phase(lds, 1024, 1024, 1024, S, E);
    } SEAM(9);
    if (IN(10)) {
        SchedAttn S; S.G = G; S.c = c; S.A = (const char*)(ws + WS_PR); S.B = (const char*)(ws + WS_VWOT);
        EpiResid E{(bf16_t*)(ws + WS_XB), SSQ, 1.0f};
        pg8::gemm_phase(lds, 1024, 1024, 1024, S, E);
    } SEAM(10);
    if (IN(11)) {
        SchedPlain S2; S2.o.init(T / 256, 5632 / 256, G, c); S2.A = XB; S2.B = (const char*)(ws + W_1C2); S2.ta = (size_t)256 * 1024 * 2; S2.tb = (size_t)256 * 1024 * 2;
        EpiSwiGLU E{(bf16_t*)(ws + WS_H), SSQ, nullptr};
        pg8::gemm_phase(lds, 1024, 1024, 1024, S2, E);
    } SEAM(11);
    if (IN(12)) {
        SchedPlain S; S.o.init(T / 256, 4, G, c); S.A = (const char*)(ws + WS_H); S.B = (const char*)(ws + W_22); S.ta = (size_t)256 * FF * 2; S.tb = (size_t)256 * FF * 2;
        EpiResid E{(bf16_t*)(ws + WS_XB), SSQ, 0.5f};
        pg8::gemm_phase(lds, FF, FF, FF, S, E);
    } SEAM(12);
    if (IN(13)) { phase_final(args); }
#undef IN
#undef SEAM
}

extern "C" void kernel_launch(void* const* d_in, const int* in_sizes, int n_in, void* d_out, int out_size, void* d_ws, size_t ws_size, hipStream_t stream) {
    static int grid = 0;
    if (grid == 0) {
        if (n_in != 27 || out_size != T * D || ws_size < WS_VWOT + 16 * MiB) { fprintf(stderr, "kernel_launch: unexpected problem (n_in %d out %d ws %zu, need ws >= %zu)\n", n_in, out_size, ws_size, (size_t)(WS_VWOT + 16 * MiB)); grid = -1; return; }
        int dev = 0, cus = 0, per_cu = 0;
        (void)hipGetDevice(&dev); (void)hipDeviceGetAttribute(&cus, hipDeviceAttributeMultiprocessorCount, dev);
        if (hipFuncSetAttribute((const void*)hybrid_fwd, hipFuncAttributeMaxDynamicSharedMemorySize, LDS_BYTES) != hipSuccess) { fprintf(stderr, "kernel_launch: hipFuncSetAttribute failed\n"); grid = -1; return; }
        (void)hipOccupancyMaxActiveBlocksPerMultiprocessor(&per_cu, (const void*)hybrid_fwd, 512, LDS_BYTES);
        (void)hipGetLastError();
        if (per_cu < 1) per_cu = 1;
        grid = cus * per_cu;
    }
    if (grid < 0) return;
    Args a{};
    for (int i = 0; i < 27; ++i) a.in[i] = (const float*)d_in[i];
    a.out = (float*)d_out; a.ws = (unsigned char*)d_ws;
#if MK_ONE_LAUNCH
    a.ph_lo = 0; a.ph_hi = NPHASE;
    void* kargs[] = {&a};
    hipError_t e = hipLaunchCooperativeKernel((const void*)hybrid_fwd, dim3(grid), dim3(512), kargs, LDS_BYTES, stream);
    if (e != hipSuccess) fprintf(stderr, "cooperative launch failed: %s (grid %d)\n", hipGetErrorString(e), grid);
#else
    for (int p = 0; p < NPHASE; ++p) { a.ph_lo = p; a.ph_hi = p + 1; hipLaunchKernelGGL(hybrid_fwd, dim3(grid), dim3(512), LDS_BYTES, stream, a); }
#endif
}
```
